# Optimizing an MI355X kernel written in HIP

```python
import jax, jax.numpy as jnp
from jax import lax
import numpy as np

D_MODEL = 2048
BATCH = 2
SEQ = 4096
DEPTH = 1

CHUNK = 64
Q_BLOCK = 2 * CHUNK
POOL_WIDTH = D_MODEL // 2
POOL_WINDOWS = (2, 4, 8, 16)
POOL_GROUPS = len(POOL_WINDOWS)
POOL_GROUP_WIDTH = POOL_WIDTH // POOL_GROUPS
SB_WIDTH = D_MODEL - POOL_WIDTH
SB_HEAD_DIM = 128
SB_HEADS = SB_WIDTH // SB_HEAD_DIM
MIX_WIDTH = POOL_WIDTH + SB_WIDTH
IN_PROJ_WIDTH = POOL_WIDTH + 3 * SB_WIDTH
D_FF = 4 * D_MODEL
DEEPNORM_ALPHA = (2.0 * DEPTH) ** 0.25
DEEPNORM_BETA = (8.0 * DEPTH) ** -0.25
LN_EPS = 1e-5

kernel_name = "hybrid_pool_stickbreaking_deepnorm_block"


def layer_norm(x, g, b):
    xf = x.astype(jnp.float32)
    mu = jnp.mean(xf, axis=-1, keepdims=True)
    var = jnp.mean(jnp.square(xf - mu), axis=-1, keepdims=True)
    y = (xf - mu) * lax.rsqrt(var + LN_EPS)
    return (y * g.astype(jnp.float32) + b.astype(jnp.float32)).astype(x.dtype)


def multi_scale_pool(u, w_pool, pool_scale):
    b, s, _ = u.shape
    ug = u.reshape(b, s, POOL_GROUPS, POOL_GROUP_WIDTH).astype(jnp.float32)
    csum = jnp.concatenate(
        [jnp.zeros((b, 1, POOL_GROUPS, POOL_GROUP_WIDTH), jnp.float32),
         jnp.cumsum(ug, axis=1)], axis=1)
    t = jnp.arange(s, dtype=jnp.int32)
    windows = jnp.asarray(POOL_WINDOWS, dtype=jnp.int32)
    start = jnp.maximum(t[:, None] + 1 - windows[None, :], 0)
    count = (t[:, None] + 1 - start).astype(jnp.float32)
    group_idx = jnp.arange(POOL_GROUPS, dtype=jnp.int32)[None, :]
    c_start = csum[:, start, group_idx]
    mean = (csum[:, 1:] - c_start) / count[None, :, :, None]
    y = mean - ug
    y = jnp.einsum('bsgc,gcd->bsgd', y, w_pool.astype(jnp.float32))
    y = y * pool_scale.astype(jnp.float32)[None, None]
    return y.reshape(b, s, POOL_WIDTH).astype(u.dtype)


def stick_breaking_attention(q, k, v):
    b, s, h, dh = q.shape
    n_blocks = s // Q_BLOCK
    scale = 1.0 / np.sqrt(dh).astype(np.float32)
    qb = q.reshape(b, n_blocks, Q_BLOCK, h, dh).transpose(1, 0, 2, 3, 4)
    key_pos = jnp.arange(s, dtype=jnp.int32)

    def one_block(args):
        qi, i = args
        z = jnp.einsum('bqhd,bkhd->bhqk', qi, k).astype(jnp.float32) * scale
        q_pos = i * Q_BLOCK + jnp.arange(Q_BLOCK, dtype=jnp.int32)
        mask = (key_pos[None, :] < q_pos[:, None])[None, None]
        log_not = jnp.where(mask, jax.nn.log_sigmoid(-z), 0.0)
        after = lax.cumsum(log_not, axis=3, reverse=True) - log_not
        a = jnp.where(mask, jnp.exp(jax.nn.log_sigmoid(z) + after), 0.0)
        return jnp.einsum('bhqk,bkhd->bqhd', a.astype(v.dtype), v)

    out = lax.map(one_block, (qb, jnp.arange(n_blocks, dtype=jnp.int32)))
    return out.transpose(1, 0, 2, 3, 4).reshape(b, s, h * dh)


def setup_inputs(seed: int = 0) -> dict:
    key = jax.random.key(seed)
    ks = jax.random.split(key, 16)
    f32 = jnp.float32
    x = jax.random.normal(ks[0], (BATCH, SEQ, D_MODEL), f32)
    ln_in_g = 1.0 + 0.02 * jax.random.normal(ks[1], (D_MODEL,), f32)
    ln_in_b = 0.02 * jax.random.normal(ks[2], (D_MODEL,), f32)
    w_in = jax.random.normal(ks[3], (DEPTH, D_MODEL, IN_PROJ_WIDTH), f32) * D_MODEL ** -0.5
    w_pool = jax.random.normal(ks[4], (DEPTH, POOL_GROUPS, POOL_GROUP_WIDTH, POOL_GROUP_WIDTH), f32) * POOL_GROUP_WIDTH ** -0.5
    pool_scale = 1.0 + 0.02 * jax.random.normal(ks[5], (DEPTH, POOL_GROUPS, POOL_GROUP_WIDTH), f32)
    w_out = jax.random.normal(ks[6], (DEPTH, MIX_WIDTH, D_MODEL), f32) * (MIX_WIDTH ** -0.5 * DEEPNORM_BETA)
    ln1_g = 1.0 + 0.02 * jax.random.normal(ks[7], (DEPTH, D_MODEL), f32)
    ln1_b = 0.02 * jax.random.normal(ks[8], (DEPTH, D_MODEL), f32)
    w_ff1 = jax.random.normal(ks[9], (DEPTH, D_MODEL, D_FF), f32) * D_MODEL ** -0.5
    b_ff1 = 0.02 * jax.random.normal(ks[10], (DEPTH, D_FF), f32)
    w_ff2 = jax.random.normal(ks[11], (DEPTH, D_FF, D_MODEL), f32) * (D_FF ** -0.5 * DEEPNORM_BETA)
    b_ff2 = 0.02 * jax.random.normal(ks[12], (DEPTH, D_MODEL), f32)
    ln2_g = 1.0 + 0.02 * jax.random.normal(ks[13], (DEPTH, D_MODEL), f32)
    ln2_b = 0.02 * jax.random.normal(ks[14], (DEPTH, D_MODEL), f32)
    return {"x": x, "ln_in_g": ln_in_g, "ln_in_b": ln_in_b, "w_in": w_in,
            "w_pool": w_pool, "pool_scale": pool_scale, "w_out": w_out,
            "ln1_g": ln1_g, "ln1_b": ln1_b, "w_ff1": w_ff1, "b_ff1": b_ff1,
            "w_ff2": w_ff2, "b_ff2": b_ff2, "ln2_g": ln2_g, "ln2_b": ln2_b}


def reference(x, ln_in_g, ln_in_b, w_in, w_pool, pool_scale, w_out,
              ln1_g, ln1_b, w_ff1, b_ff1, w_ff2, b_ff2, ln2_g, ln2_b):
    b, s, _ = x.shape
    h = layer_norm(x, ln_in_g, ln_in_b)
    for layer in range(DEPTH):
        u = jnp.einsum('bsd,de->bse', h, w_in[layer])
        u_pool = u[..., :POOL_WIDTH]
        q, k, v = jnp.split(u[..., POOL_WIDTH:], 3, axis=-1)
        q = q.reshape(b, s, SB_HEADS, SB_HEAD_DIM)
        k = k.reshape(b, s, SB_HEADS, SB_HEAD_DIM)
        v = v.reshape(b, s, SB_HEADS, SB_HEAD_DIM)
        y_pool = multi_scale_pool(u_pool, w_pool[layer], pool_scale[layer])
        y_sb = stick_breaking_attention(q, k, v)
        mix = jnp.concatenate([y_pool, y_sb], axis=-1)
        mix = jnp.einsum('bse,ed->bsd', mix, w_out[layer])
        h = layer_norm(DEEPNORM_ALPHA * h + mix, ln1_g[layer], ln1_b[layer])
        f = jnp.einsum('bsd,df->bsf', h, w_ff1[layer]) + b_ff1[layer]
        f = jnp.square(jax.nn.relu(f))
        f = jnp.einsum('bsf,fd->bsd', f, w_ff2[layer]) + b_ff2[layer]
        h = layer_norm(DEEPNORM_ALPHA * h + f, ln2_g[layer], ln2_b[layer])
    return h
```

```cpp
#include <hip/hip_runtime.h>
#include <hip/hip_cooperative_groups.h>
#include <cstdio>
#include <cstdint>
namespace cg = cooperative_groups;

#ifndef MK_N_LAUNCHES
#define MK_N_LAUNCHES 1
#endif

#define LAS __attribute__((address_space(3)))
typedef unsigned short bf16_t;
typedef short bf16x8 __attribute__((ext_vector_type(8)));
typedef float f32x4 __attribute__((ext_vector_type(4)));
typedef float f32x16 __attribute__((ext_vector_type(16)));
typedef unsigned u32x4 __attribute__((ext_vector_type(4)));
typedef unsigned u32x2 __attribute__((ext_vector_type(2)));
typedef short s16x4 __attribute__((ext_vector_type(4)));

constexpr int BATCH = 2, SEQ = 4096, DM = 2048, M = BATCH * SEQ;
constexpr int POOLW = 1024, SBW = 1024, HD = 128, NH = 8, NIN = 4096, DFF = 8192;
constexpr float LN_EPS = 1e-5f;
constexpr float ALPHA = 1.189207115002721f;
constexpr int NWAVES = 8;

namespace pg8 {
constexpr int BM = 256, BK = 64, HALF = 128, HTB = HALF * BK * 2, STAGE_BYTES = 8 * HTB, NXCD = 8, WGM = 8;
__host__ __device__ __forceinline__ int lds_byte(int r, int c) { const int st = (r >> 4) * 2 + (c >> 5), rr = r & 15, cc = c & 31, ob = rr * 64 + cc * 2; return st * 1024 + (ob ^ (((ob >> 9) & 1) << 5)); }
__host__ __device__ __forceinline__ void stage_rc(int b, int& R, int& C) { const int st = b / 1024, sb = b % 1024, swz = sb ^ (((sb >> 9) & 1) << 5); R = (st >> 1) * 16 + swz / 64; C = (st & 1) * 32 + (swz % 64) / 2; }
__host__ __device__ __forceinline__ int perm32(int rho) { const int n = rho >> 4, i = rho & 15; return 8 * (i >> 2) + 4 * n + (i & 3); }

struct Unit { int pm, pn; };
struct Gemm { const bf16_t* A; const bf16_t* Bt; int M, N, K; int lda, ldb; int a_pn_bytes; };

struct StaticOrder {
    int nM, nN, nwg, G, c;
    __host__ __device__ void init(int M_, int N_, int G_, int c_) { nM = M_ / BM; nN = N_ / BM; nwg = nM * nN; G = G_; c = c_; }
    __host__ __device__ bool next(int i, Unit& u) const {
        const long L = (long)i * G + c; if (L >= nwg) return false;
        int wgid = (int)L; { const int q = nwg / NXCD, r = nwg % NXCD, xcd = wgid % NXCD, off = wgid / NXCD; wgid = (xcd < r ? xcd * (q + 1) : r * (q + 1) + (xcd - r) * q) + off; }
        const int nig = WGM * nN, gid = wgid / nig, fm = gid * WGM, gsz = (nM - fm) < WGM ? (nM - fm) : WGM;
        u.pm = fm + ((wgid % nig) % gsz); u.pn = (wgid % nig) / gsz; return true;
    }
};

__device__ __forceinline__ unsigned cvt_pk_bf16(float lo, float hi) { unsigned r; asm volatile("v_cvt_pk_bf16_f32 %0, %1, %2" : "=v"(r) : "v"(lo), "v"(hi)); return r; }

template <int ACT> struct EpiBf16 {
    static constexpr bool PERM = true;
    bf16_t* O; int ldc; const float* bias; const float* cscale;
    __device__ __forceinline__ void operator()(const f32x4 (&acc)[2][2][4][2], const Unit& u, int wr, int wc, int fr, int fq) const {
        const int row0 = u.pm * BM + wr * 64 + fr; const int col0 = u.pn * BM + wc * 32 + 8 * fq;
        f32x4 bv[2][2], sv[2][2];
#pragma unroll
        for (int bj = 0; bj < 2; ++bj)
#pragma unroll
            for (int n = 0; n < 2; ++n) { bv[bj][n] = bias ? *(const f32x4*)(bias + col0 + bj * HALF + 4 * n) : (f32x4){0.f, 0.f, 0.f, 0.f};
                                          sv[bj][n] = cscale ? *(const f32x4*)(cscale + col0 + bj * HALF + 4 * n) : (f32x4){1.f, 1.f, 1.f, 1.f}; }
#pragma unroll
        for (int ai = 0; ai < 2; ++ai)
#pragma unroll
            for (int m = 0; m < 4; ++m) { bf16_t* rowp = O + (size_t)(row0 + ai * HALF + m * 16) * ldc + col0;
#pragma unroll
                for (int bj = 0; bj < 2; ++bj) { f32x4 v0 = acc[ai][bj][m][0] + bv[bj][0], v1 = acc[ai][bj][m][1] + bv[bj][1];
                    if (ACT == 2) {
#pragma unroll
                        for (int e = 0; e < 4; ++e) { float a = fmaxf(v0[e], 0.f), b = fmaxf(v1[e], 0.f); v0[e] = a * a; v1[e] = b * b; } }
                    v0 = v0 * sv[bj][0]; v1 = v1 * sv[bj][1];
                    u32x4 w; w.x = cvt_pk_bf16(v0[0], v0[1]); w.y = cvt_pk_bf16(v0[2], v0[3]); w.z = cvt_pk_bf16(v1[0], v1[1]); w.w = cvt_pk_bf16(v1[2], v1[3]);
                    *(u32x4*)(rowp + bj * HALF) = w; } }
    }
};

struct EpiResF32 {
    static constexpr bool PERM = false;
    const float* src; float* out; int ldc; const float* bias; const float* mean; const float* rstd; const float* g; const float* b; float alpha;
    __device__ __forceinline__ void operator()(const f32x4 (&acc)[2][2][4][2], const Unit& u, int wr, int wc, int fr, int fq) const {
        const int col0 = u.pn * BM + wc * 32 + 4 * fq; const int row0 = u.pm * BM + wr * 64 + fr;
#pragma unroll
        for (int ai = 0; ai < 2; ++ai)
#pragma unroll
            for (int m = 0; m < 4; ++m) { const int r = row0 + ai * HALF + m * 16; const float mu = mean[r], rs = rstd[r]; const size_t off = (size_t)r * ldc + col0;
#pragma unroll
                for (int bj = 0; bj < 2; ++bj)
#pragma unroll
                    for (int n = 0; n < 2; ++n) { const int c = col0 + bj * HALF + n * 16;
                        const f32x4 gv = *(const f32x4*)(g + c), bv = *(const f32x4*)(b + c);
                        f32x4 biasv = bias ? *(const f32x4*)(bias + c) : (f32x4){0.f, 0.f, 0.f, 0.f};
                        const f32x4 s = *(const f32x4*)(src + off + bj * HALF + n * 16);
                        const f32x4 h = (s - mu) * rs * gv + bv;
                        const f32x4 o = acc[ai][bj][m][n] + biasv + h * alpha;
                        *(f32x4*)(out + off + bj * HALF + n * 16) = o; }
                asm volatile("" ::: "memory"); }
    }
};

template <class Epi, class Sched, bool ALIGN_EPI = true>
__device__ __forceinline__ void gemm_phase(LAS unsigned char* lds, const Gemm g, const Sched& S, const Epi& E) {
    const int tid = threadIdx.x, wid = __builtin_amdgcn_readfirstlane(tid >> 6), lane = tid & 63, wr = wid >> 2, wc = wid & 3, fr = lane & 15, fq = lane >> 4;
    const int K = g.K, nt = K / BK;
    unsigned voffA[2], voffB[2];
#pragma unroll
    for (int i = 0; i < 2; ++i) { int R, C; stage_rc(tid * 16 + i * 8192, R, C); const int Rb = Epi::PERM ? ((R & ~31) + perm32(R & 31)) : R;
        voffA[i] = (unsigned)(R * g.lda + C) * 2u; voffB[i] = (unsigned)(Rb * g.ldb + C) * 2u; }
    const size_t kstep = (size_t)(BK * 2);
    const size_t hstepA = (size_t)HALF * g.lda * 2, hstepB = (size_t)HALF * g.ldb * 2;
    const size_t tstepA = 2 * hstepA, tstepB = 2 * hstepB;
    const unsigned ldsw = (unsigned)wid * 1024u;
    const int aoff = lds_byte(wr * 64 + fr, fq * 8), boff = lds_byte(wc * 32 + fr, fq * 8);
#define PG8_SA(b, h) (((b) * 2 + (h)) * HTB)
#define PG8_SB(b, h) ((4 + (b) * 2 + (h)) * HTB)
#define PG8_STAGE(bufoff, gbase, voff) do { _Pragma("unroll") for (int _i = 0; _i < 2; ++_i) \
        __builtin_amdgcn_global_load_lds((const unsigned*)((const char*)(gbase) + (voff)[_i]), (LAS unsigned*)(lds + (bufoff) + ldsw + _i * 8192), 16, 0, 0); } while (0)
#define PG8_LDA(dst, b, h) do { _Pragma("unroll") for (int m = 0; m < 4; ++m) _Pragma("unroll") for (int k = 0; k < 2; ++k) dst[m][k] = *(const LAS bf16x8*)(lds + PG8_SA(b, h) + aoff + m * 2048 + k * 1024); } while (0)
#define PG8_LDB(dst, b, h) do { _Pragma("unroll") for (int n = 0; n < 2; ++n) _Pragma("unroll") for (int k = 0; k < 2; ++k) dst[n][k] = *(const LAS bf16x8*)(lds + PG8_SB(b, h) + boff + n * 2048 + k * 1024); } while (0)
#define PG8_MMA(ai, bj, At, Bt) do { __builtin_amdgcn_s_setprio(1); _Pragma("unroll") for (int m = 0; m < 4; ++m) _Pragma("unroll") for (int n = 0; n < 2; ++n) _Pragma("unroll") for (int k = 0; k < 2; ++k) \
        acc[ai][bj][m][n] = __builtin_amdgcn_mfma_f32_16x16x32_bf16(Bt[n][k], At[m][k], acc[ai][bj][m][n], 0, 0, 0); __builtin_amdgcn_s_setprio(0); } while (0)
#define PG8_WAIT_V(n) asm volatile("s_waitcnt vmcnt(" #n ")" ::: "memory")
#define PG8_WAIT_L(n) asm volatile("s_waitcnt lgkmcnt(" #n ")" ::: "memory")
#define PG8_BAR __builtin_amdgcn_s_barrier()
#define PG8_SCHED __builtin_amdgcn_sched_barrier(0)
    Unit cur, nxt; int ui = 0;
    if (!S.next(0, cur)) return;
    f32x4 acc[2][2][4][2];
#pragma unroll
    for (int a = 0; a < 2; ++a)
#pragma unroll
        for (int b = 0; b < 2; ++b)
#pragma unroll
            for (int m = 0; m < 4; ++m)
#pragma unroll
                for (int n = 0; n < 2; ++n) acc[a][b][m][n] = (f32x4){0.f, 0.f, 0.f, 0.f};
    bf16x8 At[4][2], B0[2][2], B1[2][2];
    const char* cA = (const char*)g.A + (size_t)cur.pm * tstepA + (size_t)cur.pn * g.a_pn_bytes; const char* cB = (const char*)g.Bt + (size_t)cur.pn * tstepB;
    PG8_STAGE(PG8_SB(0, 0), cB, voffB); PG8_STAGE(PG8_SB(0, 1), cB + hstepB, voffB); PG8_STAGE(PG8_SA(0, 0), cA, voffA); PG8_STAGE(PG8_SA(0, 1), cA + hstepA, voffA);
    if (wr == 1) PG8_BAR;
    PG8_WAIT_V(2); PG8_BAR;
    PG8_STAGE(PG8_SB(1, 0), cB + kstep, voffB); PG8_STAGE(PG8_SA(1, 0), cA + kstep, voffA); PG8_STAGE(PG8_SB(1, 1), cB + hstepB + kstep, voffB);
    PG8_WAIT_V(6); PG8_BAR;
    for (;;) {
        const bool has_next = S.next(ui + 1, nxt);
        const char* nA = has_next ? (const char*)g.A + (size_t)nxt.pm * tstepA + (size_t)nxt.pn * g.a_pn_bytes : cA; const char* nB = has_next ? (const char*)g.Bt + (size_t)nxt.pn * tstepB : cB;
        for (int t = 0; t < nt; t += 2) {
            const bool last = (t == nt - 2);
            const char* a1 = cA + (size_t)(t + 1) * kstep;
            const char* a2 = last ? nA : cA + (size_t)(t + 2) * kstep; const char* b2 = last ? nB : cB + (size_t)(t + 2) * kstep;
            const char* a3 = a2 + kstep; const char* b3 = b2 + kstep;
            PG8_LDB(B0, 0, 0); PG8_LDB(B1, 0, 1); PG8_SCHED; PG8_LDA(At, 0, 0); PG8_STAGE(PG8_SA(1, 1), a1 + hstepA, voffA);
            PG8_WAIT_V(8); PG8_WAIT_L(0); PG8_BAR; PG8_MMA(0, 0, At, B0); PG8_MMA(0, 1, At, B1); PG8_BAR; PG8_SCHED;
            PG8_LDA(At, 0, 1); PG8_STAGE(PG8_SB(0, 0), b2, voffB); PG8_STAGE(PG8_SB(0, 1), b2 + hstepB, voffB); PG8_STAGE(PG8_SA(0, 0), a2, voffA);
            PG8_WAIT_V(8); PG8_WAIT_L(0); PG8_BAR; PG8_MMA(1, 0, At, B0); PG8_MMA(1, 1, At, B1); PG8_BAR; PG8_SCHED;
            PG8_LDB(B0, 1, 0); PG8_LDB(B1, 1, 1); PG8_SCHED; PG8_LDA(At, 1, 0); PG8_STAGE(PG8_SA(0, 1), a2 + hstepA, voffA);
            PG8_WAIT_V(8); PG8_WAIT_L(0); PG8_BAR; PG8_MMA(0, 0, At, B0); PG8_MMA(0, 1, At, B1); PG8_BAR; PG8_SCHED;
            PG8_LDA(At, 1, 1); PG8_STAGE(PG8_SB(1, 0), b3, voffB); PG8_STAGE(PG8_SB(1, 1), b3 + hstepB, voffB); PG8_STAGE(PG8_SA(1, 0), a3, voffA);
            PG8_WAIT_V(8); PG8_WAIT_L(0); PG8_BAR; PG8_MMA(1, 0, At, B0); PG8_MMA(1, 1, At, B1); PG8_BAR; PG8_SCHED;
        }
        if constexpr (ALIGN_EPI) { if (wr == 0) PG8_BAR; }
        E(acc, cur, wr, wc, fr, fq);
        if (!has_next) break;
#pragma unroll
        for (int a = 0; a < 2; ++a)
#pragma unroll
            for (int b = 0; b < 2; ++b)
#pragma unroll
                for (int m = 0; m < 4; ++m)
#pragma unroll
                    for (int n = 0; n < 2; ++n) acc[a][b][m][n] = (f32x4){0.f, 0.f, 0.f, 0.f};
        cur = nxt; cA = nA; cB = nB; ++ui;
        if constexpr (ALIGN_EPI) { if (wr == 1) PG8_BAR; }
    }
    PG8_WAIT_V(0);
    if constexpr (!ALIGN_EPI) { if (wr == 0) PG8_BAR; }
    PG8_BAR;
#undef PG8_SA
#undef PG8_SB
#undef PG8_STAGE
#undef PG8_LDA
#undef PG8_LDB
#undef PG8_MMA
#undef PG8_WAIT_V
#undef PG8_WAIT_L
#undef PG8_BAR
#undef PG8_SCHED
}
}

constexpr size_t MiB = 1u << 20;
constexpr size_t WS_STATS = 1 * MiB;
constexpr size_t WS_WIN = 2 * MiB, WS_WPOOL = 18 * MiB, WS_WOUT = 19 * MiB, WS_W1 = 27 * MiB, WS_W2 = 59 * MiB;
constexpr size_t WS_XN = 91 * MiB;
constexpr size_t WS_U = 123 * MiB;
constexpr size_t WS_YP = 187 * MiB;
constexpr size_t WS_MIX = 203 * MiB;
constexpr size_t WS_F = 123 * MiB;
constexpr size_t WS_END = 251 * MiB;

constexpr int LDS_BYTES = 147456;

__device__ __forceinline__ unsigned f2bf(float f) { unsigned u = __builtin_bit_cast(unsigned, f); return (u + 0x7fffu + ((u >> 16) & 1u)) >> 16; }
__device__ __forceinline__ unsigned pk2(float lo, float hi) { return f2bf(lo) | (f2bf(hi) << 16); }
__device__ __forceinline__ float bf2f(unsigned short h) { return __builtin_bit_cast(float, (unsigned)h << 16); }
__device__ __forceinline__ float wave_sum(float v) {
#pragma unroll
    for (int o = 1; o < 64; o <<= 1) v += __shfl_xor(v, o);
    return v;
}

__device__ __forceinline__ void p0_transpose_item(const float* W, int K, int N, bf16_t* WT, LAS float* scr, int item, int lane) {
    const int nblk = N / 32, kb = item / nblk, nb = item % nblk, k0 = 64 * kb, n0 = 32 * nb;
#pragma unroll 8
    for (int i = 0; i < 32; ++i) { const int kk = 2 * i + (lane >> 5); scr[kk * 33 + (lane & 31)] = W[(size_t)(k0 + kk) * N + n0 + (lane & 31)]; }
    asm volatile("s_waitcnt lgkmcnt(0)" ::: "memory");
    const int c = lane & 7;
#pragma unroll
    for (int j = 0; j < 4; ++j) { const int n = (lane >> 3) + 8 * j; const LAS float* s = scr + (8 * c) * 33 + n;
        u32x4 o; o.x = pk2(s[0 * 33], s[1 * 33]); o.y = pk2(s[2 * 33], s[3 * 33]); o.z = pk2(s[4 * 33], s[5 * 33]); o.w = pk2(s[6 * 33], s[7 * 33]);
        *(u32x4*)(WT + (size_t)(n0 + n) * K + k0 + 8 * c) = o; }
    asm volatile("s_waitcnt lgkmcnt(0)" ::: "memory");
}

template <bool WRITE_BF, bool WRITE_F32>
__device__ __forceinline__ void ln_row(const float* xrow, const float* g, const float* b, bf16_t* obf, float* of32, float* mean_out, float* rstd_out, int lane) {
    const f32x4* xr = (const f32x4*)xrow + lane;
    f32x4 v[8]; float s = 0.f;
#pragma unroll
    for (int j = 0; j < 8; ++j) { v[j] = xr[64 * j]; s += (v[j].x + v[j].y) + (v[j].z + v[j].w); }
    const float mean = wave_sum(s) * (1.f / DM); float s2 = 0.f;
#pragma unroll
    for (int j = 0; j < 8; ++j) { v[j] = v[j] - mean; s2 += (v[j].x * v[j].x + v[j].y * v[j].y) + (v[j].z * v[j].z + v[j].w * v[j].w); }
    const float rstd = 1.f / sqrtf(wave_sum(s2) * (1.f / DM) + LN_EPS);
    if (mean_out && lane == 0) { *mean_out = mean; *rstd_out = rstd; }
#pragma unroll
    for (int j = 0; j < 8; ++j) {
        const f32x4 gv = ((const f32x4*)g)[lane + 64 * j], bv = ((const f32x4*)b)[lane + 64 * j];
        const f32x4 y = v[j] * rstd * gv + bv;
        if (WRITE_BF) { u32x2 w; w.x = pk2(y.x, y.y); w.y = pk2(y.z, y.w); ((u32x2*)obf)[lane + 64 * j] = w; }
        if (WRITE_F32) ((f32x4*)of32)[lane + 64 * j] = y;
    }
}

__device__ __forceinline__ void pool_item(const bf16_t* U, bf16_t* YP, int item, int lane) {
    const int g = item & 3, rc = item >> 2, w = 2 << g, t0 = rc * 32, p0 = t0 & (SEQ - 1);
    const bf16_t* up = U + (size_t)t0 * NIN + g * 256 + lane * 4;
    bf16_t* yp = YP + (size_t)t0 * POOLW + g * 256 + lane * 4;
    float s0 = 0.f, s1 = 0.f, s2 = 0.f, s3 = 0.f;
    if (p0 > 0) for (int k = 1; k < w; ++k) { const u32x2 r = *(const u32x2*)(up - (size_t)k * NIN);
        s0 += bf2f(r.x & 0xffff); s1 += bf2f(r.x >> 16); s2 += bf2f(r.y & 0xffff); s3 += bf2f(r.y >> 16); }
    for (int r = 0; r < 32; ++r) {
        const u32x2 cu = *(const u32x2*)(up + (size_t)r * NIN);
        const float c0 = bf2f(cu.x & 0xffff), c1 = bf2f(cu.x >> 16), c2 = bf2f(cu.y & 0xffff), c3 = bf2f(cu.y >> 16);
        s0 += c0; s1 += c1; s2 += c2; s3 += c3;
        const int p = p0 + r; const int cnt = (p + 1 < w) ? (p + 1) : w; const float inv = 1.f / (float)cnt;
        u32x2 o; o.x = pk2(s0 * inv - c0, s1 * inv - c1); o.y = pk2(s2 * inv - c2, s3 * inv - c3);
        *(u32x2*)(yp + (size_t)r * POOLW) = o;
        if (p - w + 1 >= 0) { const u32x2 d = *(const u32x2*)(up + (size_t)(r - w + 1) * NIN);
            s0 -= bf2f(d.x & 0xffff); s1 -= bf2f(d.x >> 16); s2 -= bf2f(d.y & 0xffff); s3 -= bf2f(d.y >> 16); }
    }
}

constexpr int VROW = 320;
constexpr int VTILE = 32 * VROW;
__device__ __forceinline__ s16x4 vtr(const LAS unsigned char* p) { return __builtin_bit_cast(s16x4, __builtin_amdgcn_ds_read_tr16_b64_v4i16((LAS s16x4*)p)); }

__device__ __forceinline__ void sb_attn_unit(const bf16_t* U, bf16_t* MIX, int b, int h, int qb, LAS unsigned char* vlds, int lane) {
    const int r32 = lane & 31, hf = lane >> 5;
    const size_t rowbase = (size_t)b * SEQ;
    const bf16_t* Qp = U + (rowbase + qb * 32 + r32) * NIN + POOLW + h * HD + hf * 64;
    bf16x8 qf[8];
#pragma unroll
    for (int s = 0; s < 8; ++s) qf[s] = *(const bf16x8*)(Qp + 8 * s);
    const bf16_t* Kb = U + rowbase * NIN + POOLW + SBW + h * HD + (size_t)r32 * NIN + hf * 64;
    const bf16_t* Vb = U + rowbase * NIN + POOLW + 2 * SBW + h * HD + (size_t)(lane >> 4) * NIN + (lane & 15) * 8;
    LAS unsigned char* vw = vlds + (lane >> 4) * VROW + (lane & 15) * 16;
    const LAS unsigned char* vr = vlds + (4 * hf + ((lane & 15) >> 2)) * VROW + (16 * ((lane >> 4) & 1) + 4 * (lane & 3)) * 2;
    f32x16 o[4];
#pragma unroll
    for (int d = 0; d < 4; ++d)
#pragma unroll
        for (int r = 0; r < 16; ++r) o[d][r] = 0.f;
    float carry = 0.f;
    const float scale = 0.08838834764831845f;
    bf16x8 kf[8]; u32x4 vreg[8];
    {
        const bf16_t* kp = Kb + (size_t)(qb * 32) * NIN; const bf16_t* vp = Vb + (size_t)(qb * 32) * NIN;
#pragma unroll
        for (int s = 0; s < 8; ++s) kf[s] = *(const bf16x8*)(kp + 8 * s);
#pragma unroll
        for (int i = 0; i < 8; ++i) vreg[i] = *(const u32x4*)(vp + (size_t)(4 * i) * NIN);
    }
    for (int kt = qb; kt >= 0; --kt) {
#pragma unroll
        for (int i = 0; i < 8; ++i) *(LAS u32x4*)(vw + (4 * i) * VROW) = vreg[i];
        f32x16 sc;
#pragma unroll
        for (int r = 0; r < 16; ++r) sc[r] = 0.f;
#pragma unroll
        for (int s = 0; s < 8; ++s) sc = __builtin_amdgcn_mfma_f32_32x32x16_bf16(kf[s], qf[s], sc, 0, 0, 0);
        if (kt > 0) {
            const bf16_t* kp = Kb + (size_t)((kt - 1) * 32) * NIN; const bf16_t* vp = Vb + (size_t)((kt - 1) * 32) * NIN;
#pragma unroll
            for (int s = 0; s < 8; ++s) kf[s] = *(const bf16x8*)(kp + 8 * s);
#pragma unroll
            for (int i = 0; i < 8; ++i) vreg[i] = *(const u32x4*)(vp + (size_t)(4 * i) * NIN);
        }
        float ln[16], lb[16];
        const bool diag = (kt == qb);
#pragma unroll
        for (int r = 0; r < 16; ++r) {
            const float z = sc[r] * scale;
            const float e = __expf(-fabsf(z));
            const float l = __logf(1.f + e);
            float lnv = -(fmaxf(z, 0.f) + l);
            float lbv = fminf(z, 0.f) - l;
            if (diag) { const int kl = 8 * (r >> 2) + 4 * hf + (r & 3); if (kl >= r32) { lnv = 0.f; lbv = -INFINITY; } }
            ln[r] = lnv; lb[r] = lbv;
        }
        float T[4], PT[4], base[4];
#pragma unroll
        for (int i = 0; i < 4; ++i) { T[i] = (ln[4 * i] + ln[4 * i + 1]) + (ln[4 * i + 2] + ln[4 * i + 3]); PT[i] = __shfl_xor(T[i], 32); }
        float run = carry;
#pragma unroll
        for (int i = 3; i >= 0; --i) { base[i] = run + (hf ? 0.f : PT[i]); run += T[i] + PT[i]; }
        carry = run;
        float a[16];
#pragma unroll
        for (int i = 0; i < 4; ++i) {
            const float a3 = base[i], a2 = a3 + ln[4 * i + 3], a1 = a2 + ln[4 * i + 2], a0 = a1 + ln[4 * i + 1];
            a[4 * i + 3] = __expf(lb[4 * i + 3] + a3); a[4 * i + 2] = __expf(lb[4 * i + 2] + a2);
            a[4 * i + 1] = __expf(lb[4 * i + 1] + a1); a[4 * i + 0] = __expf(lb[4 * i + 0] + a0);
        }
        bf16x8 pf[2];
#pragma unroll
        for (int ks = 0; ks < 2; ++ks) { u32x4 w; w.x = pk2(a[8 * ks + 0], a[8 * ks + 1]); w.y = pk2(a[8 * ks + 2], a[8 * ks + 3]); w.z = pk2(a[8 * ks + 4], a[8 * ks + 5]); w.w = pk2(a[8 * ks + 6], a[8 * ks + 7]);
            pf[ks] = __builtin_bit_cast(bf16x8, w); }
#pragma unroll
        for (int d = 0; d < 4; ++d)
#pragma unroll
            for (int ks = 0; ks < 2; ++ks) {
                const s16x4 lo = vtr(vr + (16 * ks) * VROW + d * 64), hi = vtr(vr + (16 * ks + 8) * VROW + d * 64);
                const bf16x8 vf = (bf16x8){lo[0], lo[1], lo[2], lo[3], hi[0], hi[1], hi[2], hi[3]};
                o[d] = __builtin_amdgcn_mfma_f32_32x32x16_bf16(vf, pf[ks], o[d], 0, 0, 0);
            }
        if (__all(carry < -88.f)) break;
    }
    bf16_t* Op = MIX + (rowbase + qb * 32 + r32) * DM + POOLW + h * HD + 4 * hf;
#pragma unroll
    for (int d = 0; d < 4; ++d)
#pragma unroll
        for (int i = 0; i < 4; ++i) { u32x2 w; w.x = pk2(o[d][4 * i + 0], o[d][4 * i + 1]); w.y = pk2(o[d][4 * i + 2], o[d][4 * i + 3]); *(u32x2*)(Op + 32 * d + 8 * i) = w; }
}

struct Args { const float* in[15]; float* out; unsigned char* ws; int ph_lo, ph_hi; };
constexpr int N_PHASES = 9;

__global__ void __launch_bounds__(NWAVES * 64, 2) mk_fwd(Args args) {
    extern __shared__ __attribute__((aligned(16))) unsigned char lds_raw[];
    LAS unsigned char* lds = (LAS unsigned char*)lds_raw;
    const int tid = threadIdx.x, lane = tid & 63, wave = __builtin_amdgcn_readfirstlane(tid >> 6);
    const int G = gridDim.x, bx = blockIdx.x;
    const int vcu = (G % 8 == 0) ? (bx % 8) * (G / 8) + bx / 8 : bx;
    const int gw = vcu * NWAVES + wave, NGW = G * NWAVES;
    unsigned char* ws = args.ws;
    const float* x = args.in[0]; const float* ln_in_g = args.in[1]; const float* ln_in_b = args.in[2]; const float* w_in = args.in[3]; const float* w_pool = args.in[4];
    const float* pool_scale = args.in[5]; const float* w_out = args.in[6]; const float* ln1_g = args.in[7]; const float* ln1_b = args.in[8]; const float* w_ff1 = args.in[9];
    const float* b_ff1 = args.in[10]; const float* w_ff2 = args.in[11]; const float* b_ff2 = args.in[12]; const float* ln2_g = args.in[13]; const float* ln2_b = args.in[14];
    float* out = args.out;
    float* mean0 = (float*)(ws + WS_STATS); float* rstd0 = mean0 + M; float* mean1 = rstd0 + M; float* rstd1 = mean1 + M;
    bf16_t* Win_t = (bf16_t*)(ws + WS_WIN); bf16_t* Wpool_t = (bf16_t*)(ws + WS_WPOOL); bf16_t* Wout_t = (bf16_t*)(ws + WS_WOUT); bf16_t* W1_t = (bf16_t*)(ws + WS_W1); bf16_t* W2_t = (bf16_t*)(ws + WS_W2);
    bf16_t* XN = (bf16_t*)(ws + WS_XN); bf16_t* U = (bf16_t*)(ws + WS_U); bf16_t* YP = (bf16_t*)(ws + WS_YP); bf16_t* MIX = (bf16_t*)(ws + WS_MIX); bf16_t* F = (bf16_t*)(ws + WS_F);
    const int lo = args.ph_lo, hi = args.ph_hi;
#define IN(k) (lo <= (k) && (k) < hi)
#define SEAM(k) do { if (IN(k) && IN((k) + 1)) { cg::this_grid().sync(); } } while (0)

    if (IN(0)) {
        LAS float* scr = (LAS float*)(lds + wave * 16384);
        constexpr int I_IN = (DM / 64) * (NIN / 32), I_POOL = (256 / 64) * (256 / 32), I_OUT = (DM / 64) * (DM / 32), I_1 = (DM / 64) * (DFF / 32), I_2 = (DFF / 64) * (DM / 32);
        constexpr int NITEMS = I_IN + 4 * I_POOL + I_OUT + I_1 + I_2;
        for (int it = gw; it < NITEMS; it += NGW) {
            int r = it;
            if (r < I_IN) { p0_transpose_item(w_in, DM, NIN, Win_t, scr, r, lane); continue; } r -= I_IN;
            if (r < 4 * I_POOL) { const int gi = r / I_POOL; p0_transpose_item(w_pool + gi * 65536, 256, 256, Wpool_t + gi * 65536, scr, r % I_POOL, lane); continue; } r -= 4 * I_POOL;
            if (r < I_OUT) { p0_transpose_item(w_out, DM, DM, Wout_t, scr, r, lane); continue; } r -= I_OUT;
            if (r < I_1) { p0_transpose_item(w_ff1, DM, DFF, W1_t, scr, r, lane); continue; } r -= I_1;
            p0_transpose_item(w_ff2, DFF, DM, W2_t, scr, r, lane);
        }
        for (int m = gw; m < M; m += NGW) ln_row<true, false>(x + (size_t)m * DM, ln_in_g, ln_in_b, XN + (size_t)m * DM, nullptr, mean0 + m, rstd0 + m, lane);
        asm volatile("s_waitcnt vmcnt(0) lgkmcnt(0)" ::: "memory"); __syncthreads();
    }
    SEAM(0);
    if (IN(1)) {
        pg8::Gemm g{XN, Win_t, M, NIN, DM, DM, DM, 0}; pg8::StaticOrder S; S.init(M, NIN, G, bx);
        pg8::EpiBf16<0> E{U, NIN, nullptr, nullptr};
        pg8::gemm_phase<pg8::EpiBf16<0>, pg8::StaticOrder>(lds, g, S, E);
    }
    SEAM(1);
    if (IN(2)) {
        LAS unsigned char* vl = lds + wave * VTILE;
        for (int u = gw; u < BATCH * NH * (SEQ / 32); u += NGW) {
            const int qb = u & 127, bh = u >> 7;
            sb_attn_unit(U, MIX, bh >> 3, bh & 7, qb, vl, lane);
        }
        for (int it = gw; it < (M / 32) * 4; it += NGW) pool_item(U, YP, it, lane);
        asm volatile("s_waitcnt vmcnt(0) lgkmcnt(0)" ::: "memory"); __syncthreads();
    }
    SEAM(2);
    if (IN(3)) {
        pg8::Gemm g{YP, Wpool_t, M, POOLW, 256, POOLW, 256, 512}; pg8::StaticOrder S; S.init(M, POOLW, G, bx);
        pg8::EpiBf16<0> E{MIX, DM, nullptr, pool_scale};
        pg8::gemm_phase<pg8::EpiBf16<0>, pg8::StaticOrder>(lds, g, S, E);
    }
    SEAM(3);
    if (IN(4)) {
        pg8::Gemm g{MIX, Wout_t, M, DM, DM, DM, DM, 0}; pg8::StaticOrder S; S.init(M, DM, G, bx);
        pg8::EpiResF32 E{x, out, DM, nullptr, mean0, rstd0, ln_in_g, ln_in_b, ALPHA};
        pg8::gemm_phase<pg8::EpiResF32, pg8::StaticOrder>(lds, g, S, E);
    }
    SEAM(4);
    if (IN(5)) {
        for (int m = gw; m < M; m += NGW) ln_row<true, false>(out + (size_t)m * DM, ln1_g, ln1_b, XN + (size_t)m * DM, nullptr, mean1 + m, rstd1 + m, lane);
    }
    SEAM(5);
    if (IN(6)) {
        pg8::Gemm g{XN, W1_t, M, DFF, DM, DM, DM, 0}; pg8::StaticOrder S; S.init(M, DFF, G, bx);
        pg8::EpiBf16<2> E{F, DFF, b_ff1, nullptr};
        pg8::gemm_phase<pg8::EpiBf16<2>, pg8::StaticOrder>(lds, g, S, E);
    }
    SEAM(6);
    if (IN(7)) {
        pg8::Gemm g{F, W2_t, M, DM, DFF, DFF, DFF, 0}; pg8::StaticOrder S; S.init(M, DM, G, bx);
        pg8::EpiResF32 E{out, out, DM, b_ff2, mean1, rstd1, ln1_g, ln1_b, ALPHA};
        pg8::gemm_phase<pg8::EpiResF32, pg8::StaticOrder>(lds, g, S, E);
    }
    SEAM(7);
    if (IN(8)) {
        for (int m = gw; m < M; m += NGW) ln_row<false, true>(out + (size_t)m * DM, ln2_g, ln2_b, nullptr, out + (size_t)m * DM, nullptr, nullptr, lane);
    }
#undef IN
#undef SEAM
}

extern "C" void kernel_launch(void* const* d_in, const int* in_sizes, int n_in, void* d_out, int out_size, void* d_ws, size_t ws_size, hipStream_t stream) {
    static int grid = 0;
    if (grid == 0) {
        if (n_in != 15 || in_sizes[0] != M * DM || out_size != M * DM || ws_size < WS_END) { fprintf(stderr, "kernel_launch: unexpected shapes (n_in %d, in0 %d, out %d, ws %zu)\n", n_in, n_in > 0 ? in_sizes[0] : -1, out_size, ws_size); grid = -1; return; }
        int dev = 0, cus = 0, per_cu = 0;
        hipGetDevice(&dev); hipDeviceGetAttribute(&cus, hipDeviceAttributeMultiprocessorCount, dev);
        if (hipFuncSetAttribute((const void*)mk_fwd, hipFuncAttributeMaxDynamicSharedMemorySize, LDS_BYTES) != hipSuccess) { fprintf(stderr, "kernel_launch: hipFuncSetAttribute failed\n"); grid = -1; return; }
        if (hipOccupancyMaxActiveBlocksPerMultiprocessor(&per_cu, (const void*)mk_fwd, NWAVES * 64, LDS_BYTES) != hipSuccess || per_cu < 1) { fprintf(stderr, "kernel_launch: occupancy query says %d\n", per_cu); per_cu = 1; }
        (void)hipGetLastError();
        grid = cus * 1;
        if (grid <= 0) grid = 256;
    }
    if (grid < 0) return;
    Args a{};
    for (int i = 0; i < 15; ++i) a.in[i] = (const float*)d_in[i];
    a.out = (float*)d_out; a.ws = (unsigned char*)d_ws;
#if MK_N_LAUNCHES == 1
    a.ph_lo = 0; a.ph_hi = N_PHASES;
    void* kargs[] = {&a};
    hipError_t e = hipLaunchCooperativeKernel((const void*)mk_fwd, dim3(grid), dim3(NWAVES * 64), kargs, LDS_BYTES, stream);
    if (e != hipSuccess) fprintf(stderr, "cooperative launch failed: %s (grid %d)\n", hipGetErrorString(e), grid);
#else
    for (int p = 0; p < N_PHASES; ++p) { a.ph_lo = p; a.ph_hi = p + 1; hipLaunchKernelGGL(mk_fwd, dim3(grid), dim3(NWAVES * 64), LDS_BYTES, stream, a); }
#endif
}
```

```cpp
#include <hip/hip_runtime.h>
#include <hip/hip_cooperative_groups.h>
#include <cstdio>
#include <cstdint>
namespace cg = cooperative_groups;

#ifndef MK_N_LAUNCHES
#define MK_N_LAUNCHES 1
#endif

#define LAS __attribute__((address_space(3)))
typedef unsigned short bf16_t;
typedef short bf16x8 __attribute__((ext_vector_type(8)));
typedef float f32x4 __attribute__((ext_vector_type(4)));
typedef float f32x16 __attribute__((ext_vector_type(16)));
typedef unsigned u32x4 __attribute__((ext_vector_type(4)));
typedef unsigned u32x2 __attribute__((ext_vector_type(2)));
typedef short s16x4 __attribute__((ext_vector_type(4)));

constexpr int BATCH = 2, SEQ = 4096, DM = 2048, M = BATCH * SEQ;
constexpr int POOLW = 1024, SBW = 1024, HD = 128, NH = 8, NIN = 4096, DFF = 8192;
constexpr float LN_EPS = 1e-5f;
constexpr float ALPHA = 1.189207115002721f;
constexpr int NWAVES = 8;

namespace pg8 {
constexpr int BM = 256, BK = 64, HALF = 128, HTB = HALF * BK * 2, STAGE_BYTES = 8 * HTB, NXCD = 8, WGM = 8;
__host__ __device__ __forceinline__ int lds_byte(int r, int c) { const int st = (r >> 4) * 2 + (c >> 5), rr = r & 15, cc = c & 31, ob = rr * 64 + cc * 2; return st * 1024 + (ob ^ (((ob >> 9) & 1) << 5)); }
__host__ __device__ __forceinline__ void stage_rc(int b, int& R, int& C) { const int st = b / 1024, sb = b % 1024, swz = sb ^ (((sb >> 9) & 1) << 5); R = (st >> 1) * 16 + swz / 64; C = (st & 1) * 32 + (swz % 64) / 2; }
__host__ __device__ __forceinline__ int perm32(int rho) { const int n = rho >> 4, i = rho & 15; return 8 * (i >> 2) + 4 * n + (i & 3); }

struct Unit { int pm, pn; };
struct Gemm { const bf16_t* A; const bf16_t* Bt; int M, N, K; int lda, ldb; int a_pn_bytes; };

struct StaticOrder {
    int nM, nN, nwg, G, c;
    __host__ __device__ void init(int M_, int N_, int G_, int c_) { nM = M_ / BM; nN = N_ / BM; nwg = nM * nN; G = G_; c = c_; }
    __host__ __device__ bool next(int i, Unit& u) const {
        const long L = (long)i * G + c; if (L >= nwg) return false;
        int wgid = (int)L; { const int q = nwg / NXCD, r = nwg % NXCD, xcd = wgid % NXCD, off = wgid / NXCD; wgid = (xcd < r ? xcd * (q + 1) : r * (q + 1) + (xcd - r) * q) + off; }
        const int nig = WGM * nN, gid = wgid / nig, fm = gid * WGM, gsz = (nM - fm) < WGM ? (nM - fm) : WGM;
        u.pm = fm + ((wgid % nig) % gsz); u.pn = (wgid % nig) / gsz; return true;
    }
};

__device__ __forceinline__ unsigned cvt_pk_bf16(float lo, float hi) { unsigned r; asm volatile("v_cvt_pk_bf16_f32 %0, %1, %2" : "=v"(r) : "v"(lo), "v"(hi)); return r; }

template <int ACT> struct EpiBf16 {
    static constexpr bool PERM = true;
    bf16_t* O; int ldc; const float* bias; const float* cscale;
    __device__ __forceinline__ void operator()(const f32x4 (&acc)[2][2][4][2], const Unit& u, int wr, int wc, int fr, int fq) const {
        const int row0 = u.pm * BM + wr * 64 + fr; const int col0 = u.pn * BM + wc * 32 + 8 * fq;
        f32x4 bv[2][2], sv[2][2];
#pragma unroll
        for (int bj = 0; bj < 2; ++bj)
#pragma unroll
            for (int n = 0; n < 2; ++n) { bv[bj][n] = bias ? *(const f32x4*)(bias + col0 + bj * HALF + 4 * n) : (f32x4){0.f, 0.f, 0.f, 0.f};
                                          sv[bj][n] = cscale ? *(const f32x4*)(cscale + col0 + bj * HALF + 4 * n) : (f32x4){1.f, 1.f, 1.f, 1.f}; }
#pragma unroll
        for (int ai = 0; ai < 2; ++ai)
#pragma unroll
            for (int m = 0; m < 4; ++m) { bf16_t* rowp = O + (size_t)(row0 + ai * HALF + m * 16) * ldc + col0;
#pragma unroll
                for (int bj = 0; bj < 2; ++bj) { f32x4 v0 = acc[ai][bj][m][0] + bv[bj][0], v1 = acc[ai][bj][m][1] + bv[bj][1];
                    if (ACT == 2) {
#pragma unroll
                        for (int e = 0; e < 4; ++e) { float a = fmaxf(v0[e], 0.f), b = fmaxf(v1[e], 0.f); v0[e] = a * a; v1[e] = b * b; } }
                    v0 = v0 * sv[bj][0]; v1 = v1 * sv[bj][1];
                    u32x4 w; w.x = cvt_pk_bf16(v0[0], v0[1]); w.y = cvt_pk_bf16(v0[2], v0[3]); w.z = cvt_pk_bf16(v1[0], v1[1]); w.w = cvt_pk_bf16(v1[2], v1[3]);
                    *(u32x4*)(rowp + bj * HALF) = w; } }
    }
};

struct EpiResF32 {
    static constexpr bool PERM = false;
    const float* src; float* out; int ldc; const float* bias; const float* mean; const float* rstd; const float* g; const float* b; float alpha;
    __device__ __forceinline__ void operator()(const f32x4 (&acc)[2][2][4][2], const Unit& u, int wr, int wc, int fr, int fq) const {
        const int col0 = u.pn * BM + wc * 32 + 4 * fq; const int row0 = u.pm * BM + wr * 64 + fr;
#pragma unroll
        for (int ai = 0; ai < 2; ++ai)
#pragma unroll
            for (int m = 0; m < 4; ++m) { const int r = row0 + ai * HALF + m * 16; const float mu = mean[r], rs = rstd[r]; const size_t off = (size_t)r * ldc + col0;
#pragma unroll
                for (int bj = 0; bj < 2; ++bj)
#pragma unroll
                    for (int n = 0; n < 2; ++n) { const int c = col0 + bj * HALF + n * 16;
                        const f32x4 gv = *(const f32x4*)(g + c), bv = *(const f32x4*)(b + c);
                        f32x4 biasv = bias ? *(const f32x4*)(bias + c) : (f32x4){0.f, 0.f, 0.f, 0.f};
                        const f32x4 s = *(const f32x4*)(src + off + bj * HALF + n * 16);
                        const f32x4 h = (s - mu) * rs * gv + bv;
                        const f32x4 o = acc[ai][bj][m][n] + biasv + h * alpha;
                        *(f32x4*)(out + off + bj * HALF + n * 16) = o; }
                asm volatile("" ::: "memory"); }
    }
};

template <class Epi, class Sched, bool ALIGN_EPI = true>
__device__ __forceinline__ void gemm_phase(LAS unsigned char* lds, const Gemm g, const Sched& S, const Epi& E) {
    const int tid = threadIdx.x, wid = __builtin_amdgcn_readfirstlane(tid >> 6), lane = tid & 63, wr = wid >> 2, wc = wid & 3, fr = lane & 15, fq = lane >> 4;
    const int K = g.K, nt = K / BK;
    unsigned voffA[2], voffB[2];
#pragma unroll
    for (int i = 0; i < 2; ++i) { int R, C; stage_rc(tid * 16 + i * 8192, R, C); const int Rb = Epi::PERM ? ((R & ~31) + perm32(R & 31)) : R;
        voffA[i] = (unsigned)(R * g.lda + C) * 2u; voffB[i] = (unsigned)(Rb * g.ldb + C) * 2u; }
    const size_t kstep = (size_t)(BK * 2);
    const size_t hstepA = (size_t)HALF * g.lda * 2, hstepB = (size_t)HALF * g.ldb * 2;
    const size_t tstepA = 2 * hstepA, tstepB = 2 * hstepB;
    const unsigned ldsw = (unsigned)wid * 1024u;
    const int aoff = lds_byte(wr * 64 + fr, fq * 8), boff = lds_byte(wc * 32 + fr, fq * 8);
#define PG8_SA(b, h) (((b) * 2 + (h)) * HTB)
#define PG8_SB(b, h) ((4 + (b) * 2 + (h)) * HTB)
#define PG8_STAGE(bufoff, gbase, voff) do { _Pragma("unroll") for (int _i = 0; _i < 2; ++_i) \
        __builtin_amdgcn_global_load_lds((const unsigned*)((const char*)(gbase) + (voff)[_i]), (LAS unsigned*)(lds + (bufoff) + ldsw + _i * 8192), 16, 0, 0); } while (0)
#define PG8_LDA(dst, b, h) do { _Pragma("unroll") for (int m = 0; m < 4; ++m) _Pragma("unroll") for (int k = 0; k < 2; ++k) dst[m][k] = *(const LAS bf16x8*)(lds + PG8_SA(b, h) + aoff + m * 2048 + k * 1024); } while (0)
#define PG8_LDB(dst, b, h) do { _Pragma("unroll") for (int n = 0; n < 2; ++n) _Pragma("unroll") for (int k = 0; k < 2; ++k) dst[n][k] = *(const LAS bf16x8*)(lds + PG8_SB(b, h) + boff + n * 2048 + k * 1024); } while (0)
#define PG8_MMA(ai, bj, At, Bt) do { __builtin_amdgcn_s_setprio(1); _Pragma("unroll") for (int m = 0; m < 4; ++m) _Pragma("unroll") for (int n = 0; n < 2; ++n) _Pragma("unroll") for (int k = 0; k < 2; ++k) \
        acc[ai][bj][m][n] = __builtin_amdgcn_mfma_f32_16x16x32_bf16(Bt[n][k], At[m][k], acc[ai][bj][m][n], 0, 0, 0); __builtin_amdgcn_s_setprio(0); } while (0)
#define PG8_WAIT_V(n) asm volatile("s_waitcnt vmcnt(" #n ")" ::: "memory")
#define PG8_WAIT_L(n) asm volatile("s_waitcnt lgkmcnt(" #n ")" ::: "memory")
#define PG8_BAR __builtin_amdgcn_s_barrier()
#define PG8_SCHED __builtin_amdgcn_sched_barrier(0)
    Unit cur, nxt; int ui = 0;
    if (!S.next(0, cur)) return;
    f32x4 acc[2][2][4][2];
#pragma unroll
    for (int a = 0; a < 2; ++a)
#pragma unroll
        for (int b = 0; b < 2; ++b)
#pragma unroll
            for (int m = 0; m < 4; ++m)
#pragma unroll
                for (int n = 0; n < 2; ++n) acc[a][b][m][n] = (f32x4){0.f, 0.f, 0.f, 0.f};
    bf16x8 At[4][2], B0[2][2], B1[2][2];
    const char* cA = (const char*)g.A + (size_t)cur.pm * tstepA + (size_t)cur.pn * g.a_pn_bytes; const char* cB = (const char*)g.Bt + (size_t)cur.pn * tstepB;
    PG8_STAGE(PG8_SB(0, 0), cB, voffB); PG8_STAGE(PG8_SB(0, 1), cB + hstepB, voffB); PG8_STAGE(PG8_SA(0, 0), cA, voffA); PG8_STAGE(PG8_SA(0, 1), cA + hstepA, voffA);
    if (wr == 1) PG8_BAR;
    PG8_WAIT_V(2); PG8_BAR;
    PG8_STAGE(PG8_SB(1, 0), cB + kstep, voffB); PG8_STAGE(PG8_SA(1, 0), cA + kstep, voffA); PG8_STAGE(PG8_SB(1, 1), cB + hstepB + kstep, voffB);
    PG8_WAIT_V(6); PG8_BAR;
    for (;;) {
        const bool has_next = S.next(ui + 1, nxt);
        const char* nA = has_next ? (const char*)g.A + (size_t)nxt.pm * tstepA + (size_t)nxt.pn * g.a_pn_bytes : cA; const char* nB = has_next ? (const char*)g.Bt + (size_t)nxt.pn * tstepB : cB;
        for (int t = 0; t < nt; t += 2) {
            const bool last = (t == nt - 2);
            const char* a1 = cA + (size_t)(t + 1) * kstep;
            const char* a2 = last ? nA : cA + (size_t)(t + 2) * kstep; const char* b2 = last ? nB : cB + (size_t)(t + 2) * kstep;
            const char* a3 = a2 + kstep; const char* b3 = b2 + kstep;
            PG8_LDB(B0, 0, 0); PG8_LDB(B1, 0, 1); PG8_SCHED; PG8_LDA(At, 0, 0); PG8_STAGE(PG8_SA(1, 1), a1 + hstepA, voffA);
            PG8_WAIT_V(8); PG8_WAIT_L(0); PG8_BAR; PG8_MMA(0, 0, At, B0); PG8_MMA(0, 1, At, B1); PG8_BAR; PG8_SCHED;
            PG8_LDA(At, 0, 1); PG8_STAGE(PG8_SB(0, 0), b2, voffB); PG8_STAGE(PG8_SB(0, 1), b2 + hstepB, voffB); PG8_STAGE(PG8_SA(0, 0), a2, voffA);
            PG8_WAIT_V(8); PG8_WAIT_L(0); PG8_BAR; PG8_MMA(1, 0, At, B0); PG8_MMA(1, 1, At, B1); PG8_BAR; PG8_SCHED;
            PG8_LDB(B0, 1, 0); PG8_LDB(B1, 1, 1); PG8_SCHED; PG8_LDA(At, 1, 0); PG8_STAGE(PG8_SA(0, 1), a2 + hstepA, voffA);
            PG8_WAIT_V(8); PG8_WAIT_L(0); PG8_BAR; PG8_MMA(0, 0, At, B0); PG8_MMA(0, 1, At, B1); PG8_BAR; PG8_SCHED;
            PG8_LDA(At, 1, 1); PG8_STAGE(PG8_SB(1, 0), b3, voffB); PG8_STAGE(PG8_SB(1, 1), b3 + hstepB, voffB); PG8_STAGE(PG8_SA(1, 0), a3, voffA);
            PG8_WAIT_V(8); PG8_WAIT_L(0); PG8_BAR; PG8_MMA(1, 0, At, B0); PG8_MMA(1, 1, At, B1); PG8_BAR; PG8_SCHED;
        }
        if constexpr (ALIGN_EPI) { if (wr == 0) PG8_BAR; }
        E(acc, cur, wr, wc, fr, fq);
        if (!has_next) break;
#pragma unroll
        for (int a = 0; a < 2; ++a)
#pragma unroll
            for (int b = 0; b < 2; ++b)
#pragma unroll
                for (int m = 0; m < 4; ++m)
#pragma unroll
                    for (int n = 0; n < 2; ++n) acc[a][b][m][n] = (f32x4){0.f, 0.f, 0.f, 0.f};
        cur = nxt; cA = nA; cB = nB; ++ui;
        if constexpr (ALIGN_EPI) { if (wr == 1) PG8_BAR; }
    }
    PG8_WAIT_V(0);
    if constexpr (!ALIGN_EPI) { if (wr == 0) PG8_BAR; }
    PG8_BAR;
#undef PG8_SA
#undef PG8_SB
#undef PG8_STAGE
#undef PG8_LDA
#undef PG8_LDB
#undef PG8_MMA
#undef PG8_WAIT_V
#undef PG8_WAIT_L
#undef PG8_BAR
#undef PG8_SCHED
}
}

constexpr size_t MiB = 1u << 20;
constexpr size_t WS_STATS = 1 * MiB;
constexpr size_t WS_WIN = 2 * MiB, WS_WPOOL = 18 * MiB, WS_WOUT = 19 * MiB, WS_W1 = 27 * MiB, WS_W2 = 59 * MiB;
constexpr size_t WS_XN = 91 * MiB;
constexpr size_t WS_U = 123 * MiB;
constexpr size_t WS_YP = 187 * MiB;
constexpr size_t WS_MIX = 203 * MiB;
constexpr size_t WS_F = 123 * MiB;
constexpr size_t WS_END = 251 * MiB;

constexpr int LDS_BYTES = 147456;

__device__ __forceinline__ unsigned f2bf(float f) { unsigned u = __builtin_bit_cast(unsigned, f); return (u + 0x7fffu + ((u >> 16) & 1u)) >> 16; }
__device__ __forceinline__ unsigned pk2(float lo, float hi) { return f2bf(lo) | (f2bf(hi) << 16); }
__device__ __forceinline__ float bf2f(unsigned short h) { return __builtin_bit_cast(float, (unsigned)h << 16); }
__device__ __forceinline__ float wave_sum(float v) {
#pragma unroll
    for (int o = 1; o < 64; o <<= 1) v += __shfl_xor(v, o);
    return v;
}

__device__ __forceinline__ void p0_transpose_item(const float* W, int K, int N, bf16_t* WT, LAS float* scr, int item, int lane) {
    const int nblk = N / 32, kb = item / nblk, nb = item % nblk, k0 = 64 * kb, n0 = 32 * nb;
#pragma unroll 8
    for (int i = 0; i < 32; ++i) { const int kk = 2 * i + (lane >> 5); scr[kk * 33 + (lane & 31)] = W[(size_t)(k0 + kk) * N + n0 + (lane & 31)]; }
    asm volatile("s_waitcnt lgkmcnt(0)" ::: "memory");
    const int c = lane & 7;
#pragma unroll
    for (int j = 0; j < 4; ++j) { const int n = (lane >> 3) + 8 * j; const LAS float* s = scr + (8 * c) * 33 + n;
        u32x4 o; o.x = pk2(s[0 * 33], s[1 * 33]); o.y = pk2(s[2 * 33], s[3 * 33]); o.z = pk2(s[4 * 33], s[5 * 33]); o.w = pk2(s[6 * 33], s[7 * 33]);
        *(u32x4*)(WT + (size_t)(n0 + n) * K + k0 + 8 * c) = o; }
    asm volatile("s_waitcnt lgkmcnt(0)" ::: "memory");
}

template <bool WRITE_BF, bool WRITE_F32>
__device__ __forceinline__ void ln_row(const float* xrow, const float* g, const float* b, bf16_t* obf, float* of32, float* mean_out, float* rstd_out, int lane) {
    const f32x4* xr = (const f32x4*)xrow + lane;
    f32x4 v[8]; float s = 0.f;
#pragma unroll
    for (int j = 0; j < 8; ++j) { v[j] = xr[64 * j]; s += (v[j].x + v[j].y) + (v[j].z + v[j].w); }
    const float mean = wave_sum(s) * (1.f / DM); float s2 = 0.f;
#pragma unroll
    for (int j = 0; j < 8; ++j) { v[j] = v[j] - mean; s2 += (v[j].x * v[j].x + v[j].y * v[j].y) + (v[j].z * v[j].z + v[j].w * v[j].w); }
    const float rstd = 1.f / sqrtf(wave_sum(s2) * (1.f / DM) + LN_EPS);
    if (mean_out && lane == 0) { *mean_out = mean; *rstd_out = rstd; }
#pragma unroll
    for (int j = 0; j < 8; ++j) {
        const f32x4 gv = ((const f32x4*)g)[lane + 64 * j], bv = ((const f32x4*)b)[lane + 64 * j];
        const f32x4 y = v[j] * rstd * gv + bv;
        if (WRITE_BF) { u32x2 w; w.x = pk2(y.x, y.y); w.y = pk2(y.z, y.w); ((u32x2*)obf)[lane + 64 * j] = w; }
        if (WRITE_F32) ((f32x4*)of32)[lane + 64 * j] = y;
    }
}

template <int W> __device__ __forceinline__ void pool_item8(const bf16_t* U, bf16_t* YP, int ldy, int g, int rc, int lane) {
    const int t0 = rc * 8, p0 = t0 & (SEQ - 1);
    const bf16_t* up = U + (size_t)t0 * NIN + g * 256 + lane * 4;
    bf16_t* yp = YP + (size_t)t0 * ldy + g * 256 + lane * 4;
    u32x2 r[W + 7];
#pragma unroll
    for (int j = 0; j < W + 7; ++j) { const int rel = j - (W - 1); r[j] = (p0 + rel >= 0) ? *(const u32x2*)(up + (ptrdiff_t)rel * NIN) : (u32x2){0u, 0u}; }
    float s0 = 0.f, s1 = 0.f, s2 = 0.f, s3 = 0.f;
#pragma unroll
    for (int j = 0; j < W - 1; ++j) { s0 += bf2f(r[j].x & 0xffff); s1 += bf2f(r[j].x >> 16); s2 += bf2f(r[j].y & 0xffff); s3 += bf2f(r[j].y >> 16); }
#pragma unroll
    for (int i = 0; i < 8; ++i) {
        const u32x2 cu = r[i + W - 1];
        const float c0 = bf2f(cu.x & 0xffff), c1 = bf2f(cu.x >> 16), c2 = bf2f(cu.y & 0xffff), c3 = bf2f(cu.y >> 16);
        s0 += c0; s1 += c1; s2 += c2; s3 += c3;
        const int p = p0 + i; const int cnt = (p + 1 < W) ? (p + 1) : W; const float inv = 1.f / (float)cnt;
        u32x2 o; o.x = pk2(s0 * inv - c0, s1 * inv - c1); o.y = pk2(s2 * inv - c2, s3 * inv - c3);
        *(u32x2*)(yp + (size_t)i * ldy) = o;
        const u32x2 d = r[i];
        s0 -= bf2f(d.x & 0xffff); s1 -= bf2f(d.x >> 16); s2 -= bf2f(d.y & 0xffff); s3 -= bf2f(d.y >> 16);
    }
}
__device__ __forceinline__ void pool_item(const bf16_t* U, bf16_t* YP, int ldy, int item, int lane) {
    const int g = item & 3, rc = item >> 2;
    if (g == 0) pool_item8<2>(U, YP, ldy, 0, rc, lane); else if (g == 1) pool_item8<4>(U, YP, ldy, 1, rc, lane); else if (g == 2) pool_item8<8>(U, YP, ldy, 2, rc, lane); else pool_item8<16>(U, YP, ldy, 3, rc, lane);
}

constexpr int VROW = 320;
constexpr int VTILE = 32 * VROW;
__device__ __forceinline__ s16x4 vtr(const LAS unsigned char* p) { return __builtin_bit_cast(s16x4, __builtin_amdgcn_ds_read_tr16_b64_v4i16((LAS s16x4*)p)); }

__device__ __forceinline__ void sb_attn_unit(const bf16_t* U, bf16_t* MIX, int b, int h, int qb, LAS unsigned char* vlds, int lane) {
    const int r32 = lane & 31, hf = lane >> 5;
    const size_t rowbase = (size_t)b * SEQ;
    const bf16_t* Qp = U + (rowbase + qb * 32 + r32) * NIN + POOLW + h * HD + hf * 64;
    bf16x8 qf[8];
#pragma unroll
    for (int s = 0; s < 8; ++s) qf[s] = *(const bf16x8*)(Qp + 8 * s);
    const bf16_t* Kb = U + rowbase * NIN + POOLW + SBW + h * HD + (size_t)r32 * NIN + hf * 64;
    const bf16_t* Vb = U + rowbase * NIN + POOLW + 2 * SBW + h * HD + (size_t)(lane >> 4) * NIN + (lane & 15) * 8;
    LAS unsigned char* vw = vlds + (lane >> 4) * VROW + (lane & 15) * 16;
    const LAS unsigned char* vr = vlds + (4 * hf + ((lane & 15) >> 2)) * VROW + (16 * ((lane >> 4) & 1) + 4 * (lane & 3)) * 2;
    f32x16 o[4];
#pragma unroll
    for (int d = 0; d < 4; ++d)
#pragma unroll
        for (int r = 0; r < 16; ++r) o[d][r] = 0.f;
    float carry = 0.f;
    const float scale = 0.08838834764831845f;
    bf16x8 kf[8]; u32x4 vreg[8];
    {
        const bf16_t* kp = Kb + (size_t)(qb * 32) * NIN; const bf16_t* vp = Vb + (size_t)(qb * 32) * NIN;
#pragma unroll
        for (int s = 0; s < 8; ++s) kf[s] = *(const bf16x8*)(kp + 8 * s);
#pragma unroll
        for (int i = 0; i < 8; ++i) vreg[i] = *(const u32x4*)(vp + (size_t)(4 * i) * NIN);
    }
    for (int kt = qb; kt >= 0; --kt) {
#pragma unroll
        for (int i = 0; i < 8; ++i) *(LAS u32x4*)(vw + (4 * i) * VROW) = vreg[i];
        f32x16 sc;
#pragma unroll
        for (int r = 0; r < 16; ++r) sc[r] = 0.f;
#pragma unroll
        for (int s = 0; s < 8; ++s) sc = __builtin_amdgcn_mfma_f32_32x32x16_bf16(kf[s], qf[s], sc, 0, 0, 0);
        if (kt > 0) {
            const bf16_t* kp = Kb + (size_t)((kt - 1) * 32) * NIN; const bf16_t* vp = Vb + (size_t)((kt - 1) * 32) * NIN;
#pragma unroll
            for (int s = 0; s < 8; ++s) kf[s] = *(const bf16x8*)(kp + 8 * s);
#pragma unroll
            for (int i = 0; i < 8; ++i) vreg[i] = *(const u32x4*)(vp + (size_t)(4 * i) * NIN);
        }
        float ln[16], lb[16];
        const bool diag = (kt == qb);
#pragma unroll
        for (int r = 0; r < 16; ++r) {
            const float z = sc[r] * scale;
            const float e = __expf(-fabsf(z));
            const float l = __logf(1.f + e);
            float lnv = -(fmaxf(z, 0.f) + l);
            float lbv = fminf(z, 0.f) - l;
            if (diag) { const int kl = 8 * (r >> 2) + 4 * hf + (r & 3); if (kl >= r32) { lnv = 0.f; lbv = -INFINITY; } }
            ln[r] = lnv; lb[r] = lbv;
        }
        float T[4], PT[4], base[4];
#pragma unroll
        for (int i = 0; i < 4; ++i) { T[i] = (ln[4 * i] + ln[4 * i + 1]) + (ln[4 * i + 2] + ln[4 * i + 3]); PT[i] = __shfl_xor(T[i], 32); }
        float run = carry;
#pragma unroll
        for (int i = 3; i >= 0; --i) { base[i] = run + (hf ? 0.f : PT[i]); run += T[i] + PT[i]; }
        carry = run;
        float a[16];
#pragma unroll
        for (int i = 0; i < 4; ++i) {
            const float a3 = base[i], a2 = a3 + ln[4 * i + 3], a1 = a2 + ln[4 * i + 2], a0 = a1 + ln[4 * i + 1];
            a[4 * i + 3] = __expf(lb[4 * i + 3] + a3); a[4 * i + 2] = __expf(lb[4 * i + 2] + a2);
            a[4 * i + 1] = __expf(lb[4 * i + 1] + a1); a[4 * i + 0] = __expf(lb[4 * i + 0] + a0);
        }
        bf16x8 pf[2];
#pragma unroll
        for (int ks = 0; ks < 2; ++ks) { u32x4 w; w.x = pk2(a[8 * ks + 0], a[8 * ks + 1]); w.y = pk2(a[8 * ks + 2], a[8 * ks + 3]); w.z = pk2(a[8 * ks + 4], a[8 * ks + 5]); w.w = pk2(a[8 * ks + 6], a[8 * ks + 7]);
            pf[ks] = __builtin_bit_cast(bf16x8, w); }
#pragma unroll
        for (int d = 0; d < 4; ++d)
#pragma unroll
            for (int ks = 0; ks < 2; ++ks) {
                const s16x4 lo = vtr(vr + (16 * ks) * VROW + d * 64), hi = vtr(vr + (16 * ks + 8) * VROW + d * 64);
                const bf16x8 vf = (bf16x8){lo[0], lo[1], lo[2], lo[3], hi[0], hi[1], hi[2], hi[3]};
                o[d] = __builtin_amdgcn_mfma_f32_32x32x16_bf16(vf, pf[ks], o[d], 0, 0, 0);
            }
        if (__all(carry < -88.f)) break;
    }
    bf16_t* Op = MIX + (rowbase + qb * 32 + r32) * DM + POOLW + h * HD + 4 * hf;
#pragma unroll
    for (int d = 0; d < 4; ++d)
#pragma unroll
        for (int i = 0; i < 4; ++i) { u32x2 w; w.x = pk2(o[d][4 * i + 0], o[d][4 * i + 1]); w.y = pk2(o[d][4 * i + 2], o[d][4 * i + 3]); *(u32x2*)(Op + 32 * d + 8 * i) = w; }
}


#define XB_TMO      128
#define XB_XCNT(j)  (256  + 64 * (j))
#define XB_XSUB(j)  (1280 + 64 * (j))
#define XB_XGEN(j)  (2304 + 64 * (j))
#define XB_TOP      3328
#define XB_TOPGEN   3392
#define XCD_BAR_WORDS 3456
#define XB_SPIN_CAP (1u << 18)
__device__ __forceinline__ unsigned xb_ld(unsigned* p)              { return __hip_atomic_load(p, __ATOMIC_RELAXED, __HIP_MEMORY_SCOPE_AGENT); }
__device__ __forceinline__ unsigned xb_add(unsigned* p, unsigned v) { return __hip_atomic_fetch_add(p, v, __ATOMIC_RELAXED, __HIP_MEMORY_SCOPE_AGENT); }
__device__ __forceinline__ unsigned xb_xcc_id() { return (unsigned)__builtin_amdgcn_s_getreg((3 << 11) | 20) & 0xFu; }
#define XB_SPIN(cond, bar) do { unsigned _sp = 0; while (cond) { __builtin_amdgcn_s_sleep(1); \
    if ((++_sp & 255u) == 0u) { if (xb_ld(&(bar)[XB_TMO])) break; if (_sp > XB_SPIN_CAP) { atomicAdd(&(bar)[XB_TMO], 1u); break; } } } } while (0)
struct XcdBarrier { unsigned* bar; unsigned x; volatile LAS unsigned* st; };
__device__ __forceinline__ XcdBarrier xcd_barrier_post(unsigned* bar, volatile LAS unsigned* st) {
    XcdBarrier b; b.bar = bar; b.x = xb_xcc_id(); b.st = st;
    if (threadIdx.x == 0) (void)xb_add(&bar[XB_XCNT(b.x)], 1u);
    return b;
}
__device__ __forceinline__ void xcd_barrier_complete(unsigned* bar, unsigned x, unsigned& nloc, unsigned& nx) {
    const unsigned G = gridDim.x * gridDim.y * gridDim.z;
    unsigned sum, cnt, mine, sp = 0u;
    for (;;) {
        sum = 0u; cnt = 0u; mine = 0u;
#pragma unroll
        for (unsigned j = 0; j < 16; ++j) { const unsigned c = xb_ld(&bar[XB_XCNT(j)]); sum += c; cnt += (c > 0u) ? 1u : 0u; mine = (j == x) ? c : mine; }
        if (sum == G) break;
        __builtin_amdgcn_s_sleep(1);
        if ((++sp & 255u) == 0u) { if (xb_ld(&bar[XB_TMO])) break; if (sp > XB_SPIN_CAP) { atomicAdd(&bar[XB_TMO], 1u); break; } }
    }
    nloc = mine > 0u ? mine : 1u; nx = cnt > 0u ? cnt : 1u;
}
__device__ __forceinline__ void xcd_barrier(const XcdBarrier& b) {
    asm volatile("s_waitcnt vmcnt(0)" ::: "memory");
    __syncthreads();
    if (threadIdx.x == 0) {
        unsigned* bar = b.bar;
        __builtin_amdgcn_s_waitcnt(0);
        unsigned nloc = b.st[0], nx = b.st[1];
        if (nloc == 0u) { xcd_barrier_complete(bar, b.x, nloc, nx); b.st[0] = nloc; b.st[1] = nx; }
        const unsigned old = xb_add(&bar[XB_XSUB(b.x)], 1u);
        const unsigned gen = old / nloc;
        if (old + 1u == (gen + 1u) * nloc) {
            __builtin_amdgcn_fence(__ATOMIC_RELEASE, "agent");
            asm volatile("s_waitcnt vmcnt(0)" ::: "memory");
            const unsigned og = xb_add(&bar[XB_TOP], 1u);
            const unsigned tg = og / nx;
            if (og + 1u == (tg + 1u) * nx) xb_add(&bar[XB_TOPGEN], 1u);
            else XB_SPIN(xb_ld(&bar[XB_TOPGEN]) == tg, bar);
            __builtin_amdgcn_fence(__ATOMIC_ACQUIRE, "agent");
            xb_add(&bar[XB_XGEN(b.x)], 1u);
            asm volatile("s_waitcnt vmcnt(0)" ::: "memory");
        } else {
            XB_SPIN(xb_ld(&bar[XB_XGEN(b.x)]) == gen, bar);
            __builtin_amdgcn_fence(__ATOMIC_ACQUIRE, "agent");
            asm volatile("s_waitcnt vmcnt(0)" ::: "memory");
        }
    }
    __syncthreads();
}

struct Args { const float* in[15]; float* out; unsigned char* ws; int ph_lo, ph_hi; };
constexpr int N_PHASES = 9;

__global__ void __launch_bounds__(NWAVES * 64, 2) mk_fwd(Args args) {
    extern __shared__ __attribute__((aligned(16))) unsigned char lds_raw[];
    LAS unsigned char* lds = (LAS unsigned char*)lds_raw;
    const int tid = threadIdx.x, lane = tid & 63, wave = __builtin_amdgcn_readfirstlane(tid >> 6);
    const int G = gridDim.x, bx = blockIdx.x;
    const int vcu = (G % 8 == 0) ? (bx % 8) * (G / 8) + bx / 8 : bx;
    const int gw = vcu * NWAVES + wave, NGW = G * NWAVES;
    unsigned char* ws = args.ws;
    const float* x = args.in[0]; const float* ln_in_g = args.in[1]; const float* ln_in_b = args.in[2]; const float* w_in = args.in[3]; const float* w_pool = args.in[4];
    const float* pool_scale = args.in[5]; const float* w_out = args.in[6]; const float* ln1_g = args.in[7]; const float* ln1_b = args.in[8]; const float* w_ff1 = args.in[9];
    const float* b_ff1 = args.in[10]; const float* w_ff2 = args.in[11]; const float* b_ff2 = args.in[12]; const float* ln2_g = args.in[13]; const float* ln2_b = args.in[14];
    float* out = args.out;
    float* mean0 = (float*)(ws + WS_STATS); float* rstd0 = mean0 + M; float* mean1 = rstd0 + M; float* rstd1 = mean1 + M;
    bf16_t* Win_t = (bf16_t*)(ws + WS_WIN); bf16_t* Wpool_t = (bf16_t*)(ws + WS_WPOOL); bf16_t* Wout_t = (bf16_t*)(ws + WS_WOUT); bf16_t* W1_t = (bf16_t*)(ws + WS_W1); bf16_t* W2_t = (bf16_t*)(ws + WS_W2);
    bf16_t* XN = (bf16_t*)(ws + WS_XN); bf16_t* U = (bf16_t*)(ws + WS_U); bf16_t* YP = (bf16_t*)(ws + WS_YP); bf16_t* MIX = (bf16_t*)(ws + WS_MIX); bf16_t* F = (bf16_t*)(ws + WS_F);
    const int lo = args.ph_lo, hi = args.ph_hi;
    volatile LAS unsigned* MISC = (volatile LAS unsigned*)(lds + 131072 + 320);
    if (tid < 32) MISC[tid] = 0u;
    __syncthreads();
    if (lo > 1000) cg::this_grid().sync();
    XcdBarrier bar; bar.bar = (unsigned*)ws; bar.x = 0; bar.st = nullptr;
    if (hi - lo > 1) bar = xcd_barrier_post((unsigned*)ws, MISC + 8);
#define IN(k) (lo <= (k) && (k) < hi)
#define SEAM(k) do { if (IN(k) && IN((k) + 1)) { xcd_barrier(bar); } } while (0)

    if (IN(0)) {
        LAS float* scr = (LAS float*)(lds + wave * 16384);
        constexpr int I_IN = (DM / 64) * (NIN / 32), I_POOL = (256 / 64) * (256 / 32), I_OUT = (DM / 64) * (DM / 32), I_1 = (DM / 64) * (DFF / 32), I_2 = (DFF / 64) * (DM / 32);
        constexpr int NITEMS = I_IN + 4 * I_POOL + I_OUT + I_1 + I_2;
        for (int it = gw; it < NITEMS; it += NGW) {
            int r = it;
            if (r < I_IN) { p0_transpose_item(w_in, DM, NIN, Win_t, scr, r, lane); continue; } r -= I_IN;
            if (r < 4 * I_POOL) { const int gi = r / I_POOL; p0_transpose_item(w_pool + gi * 65536, 256, 256, Wpool_t + gi * 65536, scr, r % I_POOL, lane); continue; } r -= 4 * I_POOL;
            if (r < I_OUT) { p0_transpose_item(w_out, DM, DM, Wout_t, scr, r, lane); continue; } r -= I_OUT;
            if (r < I_1) { p0_transpose_item(w_ff1, DM, DFF, W1_t, scr, r, lane); continue; } r -= I_1;
            p0_transpose_item(w_ff2, DFF, DM, W2_t, scr, r, lane);
        }
        for (int m = gw; m < M; m += NGW) ln_row<true, false>(x + (size_t)m * DM, ln_in_g, ln_in_b, XN + (size_t)m * DM, nullptr, mean0 + m, rstd0 + m, lane);
        asm volatile("s_waitcnt vmcnt(0) lgkmcnt(0)" ::: "memory"); __syncthreads();
    }
    SEAM(0);
    if (IN(1)) {
        pg8::Gemm g{XN, Win_t, M, NIN, DM, DM, DM, 0}; pg8::StaticOrder S; S.init(M, NIN, G, bx);
        pg8::EpiBf16<0> E{U, NIN, nullptr, nullptr};
        pg8::gemm_phase<pg8::EpiBf16<0>, pg8::StaticOrder>(lds, g, S, E);
    }
    SEAM(1);
    if (IN(2)) {
        LAS unsigned char* vl = lds + wave * VTILE;
        for (int u = gw; u < BATCH * NH * (SEQ / 32); u += NGW) {
            const int qb = u & 127, bh = u >> 7;
            sb_attn_unit(U, MIX, bh >> 3, bh & 7, qb, vl, lane);
        }
        for (int it = gw; it < (M / 8) * 4; it += NGW) pool_item(U, YP, POOLW, it, lane);
        asm volatile("s_waitcnt vmcnt(0) lgkmcnt(0)" ::: "memory"); __syncthreads();
    }
    SEAM(2);
    if (IN(3)) {
        pg8::Gemm g{YP, Wpool_t, M, POOLW, 256, POOLW, 256, 512}; pg8::StaticOrder S; S.init(M, POOLW, G, bx);
        pg8::EpiBf16<0> E{MIX, DM, nullptr, pool_scale};
        pg8::gemm_phase<pg8::EpiBf16<0>, pg8::StaticOrder>(lds, g, S, E);
    }
    SEAM(3);
    if (IN(4)) {
        pg8::Gemm g{MIX, Wout_t, M, DM, DM, DM, DM, 0}; pg8::StaticOrder S; S.init(M, DM, G, bx);
        pg8::EpiResF32 E{x, out, DM, nullptr, mean0, rstd0, ln_in_g, ln_in_b, ALPHA};
        pg8::gemm_phase<pg8::EpiResF32, pg8::StaticOrder>(lds, g, S, E);
    }
    SEAM(4);
    if (IN(5)) {
        for (int m = gw; m < M; m += NGW) ln_row<true, false>(out + (size_t)m * DM, ln1_g, ln1_b, XN + (size_t)m * DM, nullptr, mean1 + m, rstd1 + m, lane);
    }
    SEAM(5);
    if (IN(6)) {
        pg8::Gemm g{XN, W1_t, M, DFF, DM, DM, DM, 0}; pg8::StaticOrder S; S.init(M, DFF, G, bx);
        pg8::EpiBf16<2> E{F, DFF, b_ff1, nullptr};
        pg8::gemm_phase<pg8::EpiBf16<2>, pg8::StaticOrder>(lds, g, S, E);
    }
    SEAM(6);
    if (IN(7)) {
        pg8::Gemm g{F, W2_t, M, DM, DFF, DFF, DFF, 0}; pg8::StaticOrder S; S.init(M, DM, G, bx);
        pg8::EpiResF32 E{out, out, DM, b_ff2, mean1, rstd1, ln1_g, ln1_b, ALPHA};
        pg8::gemm_phase<pg8::EpiResF32, pg8::StaticOrder>(lds, g, S, E);
    }
    SEAM(7);
    if (IN(8)) {
        for (int m = gw; m < M; m += NGW) ln_row<false, true>(out + (size_t)m * DM, ln2_g, ln2_b, nullptr, out + (size_t)m * DM, nullptr, nullptr, lane);
    }
#undef IN
#undef SEAM
}

extern "C" void kernel_launch(void* const* d_in, const int* in_sizes, int n_in, void* d_out, int out_size, void* d_ws, size_t ws_size, hipStream_t stream) {
    static int grid = 0;
    if (grid == 0) {
        if (n_in != 15 || in_sizes[0] != M * DM || out_size != M * DM || ws_size < WS_END) { fprintf(stderr, "kernel_launch: unexpected shapes (n_in %d, in0 %d, out %d, ws %zu)\n", n_in, n_in > 0 ? in_sizes[0] : -1, out_size, ws_size); grid = -1; return; }
        int dev = 0, cus = 0, per_cu = 0;
        hipGetDevice(&dev); hipDeviceGetAttribute(&cus, hipDeviceAttributeMultiprocessorCount, dev);
        if (hipFuncSetAttribute((const void*)mk_fwd, hipFuncAttributeMaxDynamicSharedMemorySize, LDS_BYTES) != hipSuccess) { fprintf(stderr, "kernel_launch: hipFuncSetAttribute failed\n"); grid = -1; return; }
        if (hipOccupancyMaxActiveBlocksPerMultiprocessor(&per_cu, (const void*)mk_fwd, NWAVES * 64, LDS_BYTES) != hipSuccess || per_cu < 1) { fprintf(stderr, "kernel_launch: occupancy query says %d\n", per_cu); per_cu = 1; }
        (void)hipGetLastError();
        grid = cus * 1;
        if (grid <= 0) grid = 256;
    }
    if (grid < 0) return;
    if (hipMemsetAsync(d_ws, 0, 16384, stream) != hipSuccess) { fprintf(stderr, "kernel_launch: memset failed\n"); return; }
    Args a{};
    for (int i = 0; i < 15; ++i) a.in[i] = (const float*)d_in[i];
    a.out = (float*)d_out; a.ws = (unsigned char*)d_ws;
#if MK_N_LAUNCHES == 1
    a.ph_lo = 0; a.ph_hi = N_PHASES;
    void* kargs[] = {&a};
    hipError_t e = hipLaunchCooperativeKernel((const void*)mk_fwd, dim3(grid), dim3(NWAVES * 64), kargs, LDS_BYTES, stream);
    if (e != hipSuccess) fprintf(stderr, "cooperative launch failed: %s (grid %d)\n", hipGetErrorString(e), grid);
#else
    for (int p = 0; p < N_PHASES; ++p) { a.ph_lo = p; a.ph_hi = p + 1; hipLaunchKernelGGL(mk_fwd, dim3(grid), dim3(NWAVES * 64), LDS_BYTES, stream, a); }
#endif
}
```

```cpp
#include <hip/hip_runtime.h>
#include <hip/hip_cooperative_groups.h>
#include <cstdio>
#include <cstdint>
namespace cg = cooperative_groups;

#ifndef MK_N_LAUNCHES
#define MK_N_LAUNCHES 1
#endif

#define LAS __attribute__((address_space(3)))
typedef unsigned short bf16_t;
typedef short bf16x8 __attribute__((ext_vector_type(8)));
typedef float f32x4 __attribute__((ext_vector_type(4)));
typedef float f32x16 __attribute__((ext_vector_type(16)));
typedef unsigned u32x4 __attribute__((ext_vector_type(4)));
typedef unsigned u32x2 __attribute__((ext_vector_type(2)));
typedef short s16x4 __attribute__((ext_vector_type(4)));

constexpr int BATCH = 2, SEQ = 4096, DM = 2048, M = BATCH * SEQ;
constexpr int POOLW = 1024, SBW = 1024, HD = 128, NH = 8, NIN = 4096, DFF = 8192;
constexpr float LN_EPS = 1e-5f;
constexpr float ALPHA = 1.189207115002721f;
constexpr int NWAVES = 8;

namespace pg8 {
constexpr int BM = 256, BK = 64, HALF = 128, HTB = HALF * BK * 2, STAGE_BYTES = 8 * HTB, NXCD = 8, WGM = 8;
__host__ __device__ __forceinline__ int lds_byte(int r, int c) { const int st = (r >> 4) * 2 + (c >> 5), rr = r & 15, cc = c & 31, ob = rr * 64 + cc * 2; return st * 1024 + (ob ^ (((ob >> 9) & 1) << 5)); }
__host__ __device__ __forceinline__ void stage_rc(int b, int& R, int& C) { const int st = b / 1024, sb = b % 1024, swz = sb ^ (((sb >> 9) & 1) << 5); R = (st >> 1) * 16 + swz / 64; C = (st & 1) * 32 + (swz % 64) / 2; }
__host__ __device__ __forceinline__ int perm32(int rho) { const int n = rho >> 4, i = rho & 15; return 8 * (i >> 2) + 4 * n + (i & 3); }

struct Unit { int pm, pn; };
struct Gemm { const bf16_t* A; const bf16_t* Bt; int M, N, K; int lda, ldb; int a_pn_bytes; };

struct StaticOrder {
    int nM, nN, nwg, G, c;
    __host__ __device__ void init(int M_, int N_, int G_, int c_) { nM = M_ / BM; nN = N_ / BM; nwg = nM * nN; G = G_; c = c_; }
    __host__ __device__ bool next(int i, Unit& u) const {
        const long L = (long)i * G + c; if (L >= nwg) return false;
        int wgid = (int)L; { const int q = nwg / NXCD, r = nwg % NXCD, xcd = wgid % NXCD, off = wgid / NXCD; wgid = (xcd < r ? xcd * (q + 1) : r * (q + 1) + (xcd - r) * q) + off; }
        const int nig = WGM * nN, gid = wgid / nig, fm = gid * WGM, gsz = (nM - fm) < WGM ? (nM - fm) : WGM;
        u.pm = fm + ((wgid % nig) % gsz); u.pn = (wgid % nig) / gsz; return true;
    }
};

__device__ __forceinline__ unsigned cvt_pk_bf16(float lo, float hi) { unsigned r; asm volatile("v_cvt_pk_bf16_f32 %0, %1, %2" : "=v"(r) : "v"(lo), "v"(hi)); return r; }

template <int ACT> struct EpiBf16 {
    static constexpr bool PERM = true;
    bf16_t* O; int ldc; const float* bias; const float* cscale;
    __device__ __forceinline__ void operator()(const f32x4 (&acc)[2][2][4][2], const Unit& u, int wr, int wc, int fr, int fq) const {
        const int row0 = u.pm * BM + wr * 64 + fr; const int col0 = u.pn * BM + wc * 32 + 8 * fq;
        f32x4 bv[2][2], sv[2][2];
#pragma unroll
        for (int bj = 0; bj < 2; ++bj)
#pragma unroll
            for (int n = 0; n < 2; ++n) { bv[bj][n] = bias ? *(const f32x4*)(bias + col0 + bj * HALF + 4 * n) : (f32x4){0.f, 0.f, 0.f, 0.f};
                                          sv[bj][n] = cscale ? *(const f32x4*)(cscale + col0 + bj * HALF + 4 * n) : (f32x4){1.f, 1.f, 1.f, 1.f}; }
#pragma unroll
        for (int ai = 0; ai < 2; ++ai)
#pragma unroll
            for (int m = 0; m < 4; ++m) { bf16_t* rowp = O + (size_t)(row0 + ai * HALF + m * 16) * ldc + col0;
#pragma unroll
                for (int bj = 0; bj < 2; ++bj) { f32x4 v0 = acc[ai][bj][m][0] + bv[bj][0], v1 = acc[ai][bj][m][1] + bv[bj][1];
                    if (ACT == 2) {
#pragma unroll
                        for (int e = 0; e < 4; ++e) { float a = fmaxf(v0[e], 0.f), b = fmaxf(v1[e], 0.f); v0[e] = a * a; v1[e] = b * b; } }
                    v0 = v0 * sv[bj][0]; v1 = v1 * sv[bj][1];
                    u32x4 w; w.x = cvt_pk_bf16(v0[0], v0[1]); w.y = cvt_pk_bf16(v0[2], v0[3]); w.z = cvt_pk_bf16(v1[0], v1[1]); w.w = cvt_pk_bf16(v1[2], v1[3]);
                    *(u32x4*)(rowp + bj * HALF) = w; } }
    }
};

struct EpiResF32 {
    static constexpr bool PERM = false;
    const float* src; float* out; int ldc; const float* bias; const float* mean; const float* rstd; const float* g; const float* b; float alpha;
    __device__ __forceinline__ void operator()(const f32x4 (&acc)[2][2][4][2], const Unit& u, int wr, int wc, int fr, int fq) const {
        const int col0 = u.pn * BM + wc * 32 + 4 * fq; const int row0 = u.pm * BM + wr * 64 + fr;
#pragma unroll
        for (int ai = 0; ai < 2; ++ai)
#pragma unroll
            for (int m = 0; m < 4; ++m) { const int r = row0 + ai * HALF + m * 16; const float mu = mean[r], rs = rstd[r]; const size_t off = (size_t)r * ldc + col0;
#pragma unroll
                for (int bj = 0; bj < 2; ++bj)
#pragma unroll
                    for (int n = 0; n < 2; ++n) { const int c = col0 + bj * HALF + n * 16;
                        const f32x4 gv = *(const f32x4*)(g + c), bv = *(const f32x4*)(b + c);
                        f32x4 biasv = bias ? *(const f32x4*)(bias + c) : (f32x4){0.f, 0.f, 0.f, 0.f};
                        const f32x4 s = *(const f32x4*)(src + off + bj * HALF + n * 16);
                        const f32x4 h = (s - mu) * rs * gv + bv;
                        const f32x4 o = acc[ai][bj][m][n] + biasv + h * alpha;
                        *(f32x4*)(out + off + bj * HALF + n * 16) = o; }
                asm volatile("" ::: "memory"); }
    }
};

template <class Epi, class Sched, bool ALIGN_EPI = true>
__device__ __forceinline__ void gemm_phase(LAS unsigned char* lds, const Gemm g, const Sched& S, const Epi& E) {
    const int tid = threadIdx.x, wid = __builtin_amdgcn_readfirstlane(tid >> 6), lane = tid & 63, wr = wid >> 2, wc = wid & 3, fr = lane & 15, fq = lane >> 4;
    const int K = g.K, nt = K / BK;
    unsigned voffA[2], voffB[2];
#pragma unroll
    for (int i = 0; i < 2; ++i) { int R, C; stage_rc(tid * 16 + i * 8192, R, C); const int Rb = Epi::PERM ? ((R & ~31) + perm32(R & 31)) : R;
        voffA[i] = (unsigned)(R * g.lda + C) * 2u; voffB[i] = (unsigned)(Rb * g.ldb + C) * 2u; }
    const size_t kstep = (size_t)(BK * 2);
    const size_t hstepA = (size_t)HALF * g.lda * 2, hstepB = (size_t)HALF * g.ldb * 2;
    const size_t tstepA = 2 * hstepA, tstepB = 2 * hstepB;
    const unsigned ldsw = (unsigned)wid * 1024u;
    const int aoff = lds_byte(wr * 64 + fr, fq * 8), boff = lds_byte(wc * 32 + fr, fq * 8);
#define PG8_SA(b, h) (((b) * 2 + (h)) * HTB)
#define PG8_SB(b, h) ((4 + (b) * 2 + (h)) * HTB)
#define PG8_STAGE(bufoff, gbase, voff) do { _Pragma("unroll") for (int _i = 0; _i < 2; ++_i) \
        __builtin_amdgcn_global_load_lds((const unsigned*)((const char*)(gbase) + (voff)[_i]), (LAS unsigned*)(lds + (bufoff) + ldsw + _i * 8192), 16, 0, 0); } while (0)
#define PG8_LDA(dst, b, h) do { _Pragma("unroll") for (int m = 0; m < 4; ++m) _Pragma("unroll") for (int k = 0; k < 2; ++k) dst[m][k] = *(const LAS bf16x8*)(lds + PG8_SA(b, h) + aoff + m * 2048 + k * 1024); } while (0)
#define PG8_LDB(dst, b, h) do { _Pragma("unroll") for (int n = 0; n < 2; ++n) _Pragma("unroll") for (int k = 0; k < 2; ++k) dst[n][k] = *(const LAS bf16x8*)(lds + PG8_SB(b, h) + boff + n * 2048 + k * 1024); } while (0)
#define PG8_MMA(ai, bj, At, Bt) do { __builtin_amdgcn_s_setprio(1); _Pragma("unroll") for (int m = 0; m < 4; ++m) _Pragma("unroll") for (int n = 0; n < 2; ++n) _Pragma("unroll") for (int k = 0; k < 2; ++k) \
        acc[ai][bj][m][n] = __builtin_amdgcn_mfma_f32_16x16x32_bf16(Bt[n][k], At[m][k], acc[ai][bj][m][n], 0, 0, 0); __builtin_amdgcn_s_setprio(0); } while (0)
#define PG8_WAIT_V(n) asm volatile("s_waitcnt vmcnt(" #n ")" ::: "memory")
#define PG8_WAIT_L(n) asm volatile("s_waitcnt lgkmcnt(" #n ")" ::: "memory")
#define PG8_BAR __builtin_amdgcn_s_barrier()
#define PG8_SCHED __builtin_amdgcn_sched_barrier(0)
    Unit cur, nxt; int ui = 0;
    if (!S.next(0, cur)) return;
    f32x4 acc[2][2][4][2];
#pragma unroll
    for (int a = 0; a < 2; ++a)
#pragma unroll
        for (int b = 0; b < 2; ++b)
#pragma unroll
            for (int m = 0; m < 4; ++m)
#pragma unroll
                for (int n = 0; n < 2; ++n) acc[a][b][m][n] = (f32x4){0.f, 0.f, 0.f, 0.f};
    bf16x8 At[4][2], B0[2][2], B1[2][2];
    const char* cA = (const char*)g.A + (size_t)cur.pm * tstepA + (size_t)cur.pn * g.a_pn_bytes; const char* cB = (const char*)g.Bt + (size_t)cur.pn * tstepB;
    PG8_STAGE(PG8_SB(0, 0), cB, voffB); PG8_STAGE(PG8_SB(0, 1), cB + hstepB, voffB); PG8_STAGE(PG8_SA(0, 0), cA, voffA); PG8_STAGE(PG8_SA(0, 1), cA + hstepA, voffA);
    if (wr == 1) PG8_BAR;
    PG8_WAIT_V(2); PG8_BAR;
    PG8_STAGE(PG8_SB(1, 0), cB + kstep, voffB); PG8_STAGE(PG8_SA(1, 0), cA + kstep, voffA); PG8_STAGE(PG8_SB(1, 1), cB + hstepB + kstep, voffB);
    PG8_WAIT_V(6); PG8_BAR;
    for (;;) {
        const bool has_next = S.next(ui + 1, nxt);
        const char* nA = has_next ? (const char*)g.A + (size_t)nxt.pm * tstepA + (size_t)nxt.pn * g.a_pn_bytes : cA; const char* nB = has_next ? (const char*)g.Bt + (size_t)nxt.pn * tstepB : cB;
        for (int t = 0; t < nt; t += 2) {
            const bool last = (t == nt - 2);
            const char* a1 = cA + (size_t)(t + 1) * kstep;
            const char* a2 = last ? nA : cA + (size_t)(t + 2) * kstep; const char* b2 = last ? nB : cB + (size_t)(t + 2) * kstep;
            const char* a3 = a2 + kstep; const char* b3 = b2 + kstep;
            PG8_LDB(B0, 0, 0); PG8_LDB(B1, 0, 1); PG8_SCHED; PG8_LDA(At, 0, 0); PG8_STAGE(PG8_SA(1, 1), a1 + hstepA, voffA);
            PG8_WAIT_V(8); PG8_WAIT_L(0); PG8_BAR; PG8_MMA(0, 0, At, B0); PG8_MMA(0, 1, At, B1); PG8_BAR; PG8_SCHED;
            PG8_LDA(At, 0, 1); PG8_STAGE(PG8_SB(0, 0), b2, voffB); PG8_STAGE(PG8_SB(0, 1), b2 + hstepB, voffB); PG8_STAGE(PG8_SA(0, 0), a2, voffA);
            PG8_WAIT_V(8); PG8_WAIT_L(0); PG8_BAR; PG8_MMA(1, 0, At, B0); PG8_MMA(1, 1, At, B1); PG8_BAR; PG8_SCHED;
            PG8_LDB(B0, 1, 0); PG8_LDB(B1, 1, 1); PG8_SCHED; PG8_LDA(At, 1, 0); PG8_STAGE(PG8_SA(0, 1), a2 + hstepA, voffA);
            PG8_WAIT_V(8); PG8_WAIT_L(0); PG8_BAR; PG8_MMA(0, 0, At, B0); PG8_MMA(0, 1, At, B1); PG8_BAR; PG8_SCHED;
            PG8_LDA(At, 1, 1); PG8_STAGE(PG8_SB(1, 0), b3, voffB); PG8_STAGE(PG8_SB(1, 1), b3 + hstepB, voffB); PG8_STAGE(PG8_SA(1, 0), a3, voffA);
            PG8_WAIT_V(8); PG8_WAIT_L(0); PG8_BAR; PG8_MMA(1, 0, At, B0); PG8_MMA(1, 1, At, B1); PG8_BAR; PG8_SCHED;
        }
        if constexpr (ALIGN_EPI) { if (wr == 0) PG8_BAR; }
        E(acc, cur, wr, wc, fr, fq);
        if (!has_next) break;
#pragma unroll
        for (int a = 0; a < 2; ++a)
#pragma unroll
            for (int b = 0; b < 2; ++b)
#pragma unroll
                for (int m = 0; m < 4; ++m)
#pragma unroll
                    for (int n = 0; n < 2; ++n) acc[a][b][m][n] = (f32x4){0.f, 0.f, 0.f, 0.f};
        cur = nxt; cA = nA; cB = nB; ++ui;
        if constexpr (ALIGN_EPI) { if (wr == 1) PG8_BAR; }
    }
    PG8_WAIT_V(0);
    if constexpr (!ALIGN_EPI) { if (wr == 0) PG8_BAR; }
    PG8_BAR;
#undef PG8_SA
#undef PG8_SB
#undef PG8_STAGE
#undef PG8_LDA
#undef PG8_LDB
#undef PG8_MMA
#undef PG8_WAIT_V
#undef PG8_WAIT_L
#undef PG8_BAR
#undef PG8_SCHED
}
}

constexpr size_t MiB = 1u << 20;
constexpr size_t WS_STATS = 1 * MiB;
constexpr size_t WS_WIN = 2 * MiB, WS_WPOOL = 18 * MiB, WS_WOUT = 19 * MiB, WS_W1 = 27 * MiB, WS_W2 = 59 * MiB;
constexpr size_t WS_XN = 91 * MiB;
constexpr size_t WS_U = 123 * MiB;
constexpr size_t WS_YP = 187 * MiB;
constexpr size_t WS_MIX = 203 * MiB;
constexpr size_t WS_F = 123 * MiB;
constexpr size_t WS_END = 251 * MiB;

constexpr int LDS_BYTES = 147456;

__device__ __forceinline__ unsigned f2bf(float f) { unsigned u = __builtin_bit_cast(unsigned, f); return (u + 0x7fffu + ((u >> 16) & 1u)) >> 16; }
__device__ __forceinline__ unsigned pk2(float lo, float hi) { return f2bf(lo) | (f2bf(hi) << 16); }
__device__ __forceinline__ float bf2f(unsigned short h) { return __builtin_bit_cast(float, (unsigned)h << 16); }
__device__ __forceinline__ float wave_sum(float v) {
#pragma unroll
    for (int o = 1; o < 64; o <<= 1) v += __shfl_xor(v, o);
    return v;
}

__device__ __forceinline__ void p0_transpose_item(const float* W, int K, int N, bf16_t* WT, LAS float* scr, int item, int lane) {
    const int nblk = N / 32, kb = item / nblk, nb = item % nblk, k0 = 64 * kb, n0 = 32 * nb;
#pragma unroll 8
    for (int i = 0; i < 32; ++i) { const int kk = 2 * i + (lane >> 5); scr[kk * 33 + (lane & 31)] = W[(size_t)(k0 + kk) * N + n0 + (lane & 31)]; }
    asm volatile("s_waitcnt lgkmcnt(0)" ::: "memory");
    const int c = lane & 7;
#pragma unroll
    for (int j = 0; j < 4; ++j) { const int n = (lane >> 3) + 8 * j; const LAS float* s = scr + (8 * c) * 33 + n;
        u32x4 o; o.x = pk2(s[0 * 33], s[1 * 33]); o.y = pk2(s[2 * 33], s[3 * 33]); o.z = pk2(s[4 * 33], s[5 * 33]); o.w = pk2(s[6 * 33], s[7 * 33]);
        *(u32x4*)(WT + (size_t)(n0 + n) * K + k0 + 8 * c) = o; }
    asm volatile("s_waitcnt lgkmcnt(0)" ::: "memory");
}

template <bool WRITE_BF, bool WRITE_F32>
__device__ __forceinline__ void ln_row(const float* xrow, const float* g, const float* b, bf16_t* obf, float* of32, float* mean_out, float* rstd_out, int lane) {
    const f32x4* xr = (const f32x4*)xrow + lane;
    f32x4 v[8]; float s = 0.f;
#pragma unroll
    for (int j = 0; j < 8; ++j) { v[j] = xr[64 * j]; s += (v[j].x + v[j].y) + (v[j].z + v[j].w); }
    const float mean = wave_sum(s) * (1.f / DM); float s2 = 0.f;
#pragma unroll
    for (int j = 0; j < 8; ++j) { v[j] = v[j] - mean; s2 += (v[j].x * v[j].x + v[j].y * v[j].y) + (v[j].z * v[j].z + v[j].w * v[j].w); }
    const float rstd = 1.f / sqrtf(wave_sum(s2) * (1.f / DM) + LN_EPS);
    if (mean_out && lane == 0) { *mean_out = mean; *rstd_out = rstd; }
#pragma unroll
    for (int j = 0; j < 8; ++j) {
        const f32x4 gv = ((const f32x4*)g)[lane + 64 * j], bv = ((const f32x4*)b)[lane + 64 * j];
        const f32x4 y = v[j] * rstd * gv + bv;
        if (WRITE_BF) { u32x2 w; w.x = pk2(y.x, y.y); w.y = pk2(y.z, y.w); ((u32x2*)obf)[lane + 64 * j] = w; }
        if (WRITE_F32) ((f32x4*)of32)[lane + 64 * j] = y;
    }
}

template <int W> __device__ __forceinline__ void pool_item8(const bf16_t* U, bf16_t* YP, int ldy, int g, int rc, int lane) {
    const int t0 = rc * 8, p0 = t0 & (SEQ - 1);
    const bf16_t* up = U + (size_t)t0 * NIN + g * 256 + lane * 4;
    bf16_t* yp = YP + (size_t)t0 * ldy + g * 256 + lane * 4;
    u32x2 r[W + 7];
#pragma unroll
    for (int j = 0; j < W + 7; ++j) { const int rel = j - (W - 1); r[j] = (p0 + rel >= 0) ? *(const u32x2*)(up + (ptrdiff_t)rel * NIN) : (u32x2){0u, 0u}; }
    float s0 = 0.f, s1 = 0.f, s2 = 0.f, s3 = 0.f;
#pragma unroll
    for (int j = 0; j < W - 1; ++j) { s0 += bf2f(r[j].x & 0xffff); s1 += bf2f(r[j].x >> 16); s2 += bf2f(r[j].y & 0xffff); s3 += bf2f(r[j].y >> 16); }
#pragma unroll
    for (int i = 0; i < 8; ++i) {
        const u32x2 cu = r[i + W - 1];
        const float c0 = bf2f(cu.x & 0xffff), c1 = bf2f(cu.x >> 16), c2 = bf2f(cu.y & 0xffff), c3 = bf2f(cu.y >> 16);
        s0 += c0; s1 += c1; s2 += c2; s3 += c3;
        const int p = p0 + i; const int cnt = (p + 1 < W) ? (p + 1) : W; const float inv = 1.f / (float)cnt;
        u32x2 o; o.x = pk2(s0 * inv - c0, s1 * inv - c1); o.y = pk2(s2 * inv - c2, s3 * inv - c3);
        *(u32x2*)(yp + (size_t)i * ldy) = o;
        const u32x2 d = r[i];
        s0 -= bf2f(d.x & 0xffff); s1 -= bf2f(d.x >> 16); s2 -= bf2f(d.y & 0xffff); s3 -= bf2f(d.y >> 16);
    }
}
__device__ __forceinline__ void pool_item(const bf16_t* U, bf16_t* YP, int ldy, int item, int lane) {
    const int g = item & 3, rc = item >> 2;
    if (g == 0) pool_item8<2>(U, YP, ldy, 0, rc, lane); else if (g == 1) pool_item8<4>(U, YP, ldy, 1, rc, lane); else if (g == 2) pool_item8<8>(U, YP, ldy, 2, rc, lane); else pool_item8<16>(U, YP, ldy, 3, rc, lane);
}

constexpr int VROW = 320;
constexpr int VTILE = 32 * VROW;
__device__ __forceinline__ s16x4 vtr(const LAS unsigned char* p) { return __builtin_bit_cast(s16x4, __builtin_amdgcn_ds_read_tr16_b64_v4i16((LAS s16x4*)p)); }

__device__ __forceinline__ void sb_attn_unit(const bf16_t* U, bf16_t* MIX, int b, int h, int qb, LAS unsigned char* vlds, int lane) {
    const int r32 = lane & 31, hf = lane >> 5;
    const size_t rowbase = (size_t)b * SEQ;
    const bf16_t* Qp = U + (rowbase + qb * 32 + r32) * NIN + POOLW + h * HD + hf * 64;
    bf16x8 qf[8];
#pragma unroll
    for (int s = 0; s < 8; ++s) qf[s] = *(const bf16x8*)(Qp + 8 * s);
    const bf16_t* Kb = U + rowbase * NIN + POOLW + SBW + h * HD + (size_t)r32 * NIN + hf * 64;
    const bf16_t* Vb = U + rowbase * NIN + POOLW + 2 * SBW + h * HD + (size_t)(lane >> 4) * NIN + (lane & 15) * 8;
    LAS unsigned char* vw = vlds + (lane >> 4) * VROW + (lane & 15) * 16;
    const LAS unsigned char* vr = vlds + (4 * hf + ((lane & 15) >> 2)) * VROW + (16 * ((lane >> 4) & 1) + 4 * (lane & 3)) * 2;
    f32x16 o[4];
#pragma unroll
    for (int d = 0; d < 4; ++d)
#pragma unroll
        for (int r = 0; r < 16; ++r) o[d][r] = 0.f;
    float carry = 0.f;
    const float scale = 0.08838834764831845f;
    bf16x8 kf[8]; u32x4 vreg[8];
    {
        const bf16_t* kp = Kb + (size_t)(qb * 32) * NIN; const bf16_t* vp = Vb + (size_t)(qb * 32) * NIN;
#pragma unroll
        for (int s = 0; s < 8; ++s) kf[s] = *(const bf16x8*)(kp + 8 * s);
#pragma unroll
        for (int i = 0; i < 8; ++i) vreg[i] = *(const u32x4*)(vp + (size_t)(4 * i) * NIN);
    }
    for (int kt = qb; kt >= 0; --kt) {
#pragma unroll
        for (int i = 0; i < 8; ++i) *(LAS u32x4*)(vw + (4 * i) * VROW) = vreg[i];
        f32x16 sc;
#pragma unroll
        for (int r = 0; r < 16; ++r) sc[r] = 0.f;
#pragma unroll
        for (int s = 0; s < 8; ++s) sc = __builtin_amdgcn_mfma_f32_32x32x16_bf16(kf[s], qf[s], sc, 0, 0, 0);
        if (kt > 0) {
            const bf16_t* kp = Kb + (size_t)((kt - 1) * 32) * NIN; const bf16_t* vp = Vb + (size_t)((kt - 1) * 32) * NIN;
#pragma unroll
            for (int s = 0; s < 8; ++s) kf[s] = *(const bf16x8*)(kp + 8 * s);
#pragma unroll
            for (int i = 0; i < 8; ++i) vreg[i] = *(const u32x4*)(vp + (size_t)(4 * i) * NIN);
        }
        float ln[16], lb[16];
        const bool diag = (kt == qb);
#pragma unroll
        for (int r = 0; r < 16; ++r) {
            const float z = sc[r] * scale;
            const float e = __expf(-fabsf(z));
            const float l = __logf(1.f + e);
            float lnv = -(fmaxf(z, 0.f) + l);
            float lbv = fminf(z, 0.f) - l;
            if (diag) { const int kl = 8 * (r >> 2) + 4 * hf + (r & 3); if (kl >= r32) { lnv = 0.f; lbv = -INFINITY; } }
            ln[r] = lnv; lb[r] = lbv;
        }
        float T[4], PT[4], base[4];
#pragma unroll
        for (int i = 0; i < 4; ++i) { T[i] = (ln[4 * i] + ln[4 * i + 1]) + (ln[4 * i + 2] + ln[4 * i + 3]); PT[i] = __shfl_xor(T[i], 32); }
        float run = carry;
#pragma unroll
        for (int i = 3; i >= 0; --i) { base[i] = run + (hf ? 0.f : PT[i]); run += T[i] + PT[i]; }
        carry = run;
        float a[16];
#pragma unroll
        for (int i = 0; i < 4; ++i) {
            const float a3 = base[i], a2 = a3 + ln[4 * i + 3], a1 = a2 + ln[4 * i + 2], a0 = a1 + ln[4 * i + 1];
            a[4 * i + 3] = __expf(lb[4 * i + 3] + a3); a[4 * i + 2] = __expf(lb[4 * i + 2] + a2);
            a[4 * i + 1] = __expf(lb[4 * i + 1] + a1); a[4 * i + 0] = __expf(lb[4 * i + 0] + a0);
        }
        bf16x8 pf[2];
#pragma unroll
        for (int ks = 0; ks < 2; ++ks) { u32x4 w; w.x = pk2(a[8 * ks + 0], a[8 * ks + 1]); w.y = pk2(a[8 * ks + 2], a[8 * ks + 3]); w.z = pk2(a[8 * ks + 4], a[8 * ks + 5]); w.w = pk2(a[8 * ks + 6], a[8 * ks + 7]);
            pf[ks] = __builtin_bit_cast(bf16x8, w); }
#pragma unroll
        for (int d = 0; d < 4; ++d)
#pragma unroll
            for (int ks = 0; ks < 2; ++ks) {
                const s16x4 lo = vtr(vr + (16 * ks) * VROW + d * 64), hi = vtr(vr + (16 * ks + 8) * VROW + d * 64);
                const bf16x8 vf = (bf16x8){lo[0], lo[1], lo[2], lo[3], hi[0], hi[1], hi[2], hi[3]};
                o[d] = __builtin_amdgcn_mfma_f32_32x32x16_bf16(vf, pf[ks], o[d], 0, 0, 0);
            }
        if (__all(carry < -88.f)) break;
    }
    bf16_t* Op = MIX + (rowbase + qb * 32 + r32) * DM + POOLW + h * HD + 4 * hf;
#pragma unroll
    for (int d = 0; d < 4; ++d)
#pragma unroll
        for (int i = 0; i < 4; ++i) { u32x2 w; w.x = pk2(o[d][4 * i + 0], o[d][4 * i + 1]); w.y = pk2(o[d][4 * i + 2], o[d][4 * i + 3]); *(u32x2*)(Op + 32 * d + 8 * i) = w; }
}


#define XB_TMO      128
#define XB_XCNT(j)  (256  + 64 * (j))
#define XB_XSUB(j)  (1280 + 64 * (j))
#define XB_XGEN(j)  (2304 + 64 * (j))
#define XB_TOP      3328
#define XB_TOPGEN   3392
#define XCD_BAR_WORDS 3456
#define XB_SPIN_CAP (1u << 18)
__device__ __forceinline__ unsigned xb_ld(unsigned* p)              { return __hip_atomic_load(p, __ATOMIC_RELAXED, __HIP_MEMORY_SCOPE_AGENT); }
__device__ __forceinline__ unsigned xb_add(unsigned* p, unsigned v) { return __hip_atomic_fetch_add(p, v, __ATOMIC_RELAXED, __HIP_MEMORY_SCOPE_AGENT); }
__device__ __forceinline__ unsigned xb_xcc_id() { return (unsigned)__builtin_amdgcn_s_getreg((3 << 11) | 20) & 0xFu; }
#define XB_SPIN(cond, bar) do { unsigned _sp = 0; while (cond) { __builtin_amdgcn_s_sleep(1); \
    if ((++_sp & 255u) == 0u) { if (xb_ld(&(bar)[XB_TMO])) break; if (_sp > XB_SPIN_CAP) { atomicAdd(&(bar)[XB_TMO], 1u); break; } } } } while (0)
struct XcdBarrier { unsigned* bar; unsigned x; volatile LAS unsigned* st; };
__device__ __forceinline__ XcdBarrier xcd_barrier_post(unsigned* bar, volatile LAS unsigned* st) {
    XcdBarrier b; b.bar = bar; b.x = xb_xcc_id(); b.st = st;
    if (threadIdx.x == 0) (void)xb_add(&bar[XB_XCNT(b.x)], 1u);
    return b;
}
__device__ __forceinline__ void xcd_barrier_complete(unsigned* bar, unsigned x, unsigned& nloc, unsigned& nx) {
    const unsigned G = gridDim.x * gridDim.y * gridDim.z;
    unsigned sum, cnt, mine, sp = 0u;
    for (;;) {
        sum = 0u; cnt = 0u; mine = 0u;
#pragma unroll
        for (unsigned j = 0; j < 16; ++j) { const unsigned c = xb_ld(&bar[XB_XCNT(j)]); sum += c; cnt += (c > 0u) ? 1u : 0u; mine = (j == x) ? c : mine; }
        if (sum == G) break;
        __builtin_amdgcn_s_sleep(1);
        if ((++sp & 255u) == 0u) { if (xb_ld(&bar[XB_TMO])) break; if (sp > XB_SPIN_CAP) { atomicAdd(&bar[XB_TMO], 1u); break; } }
    }
    nloc = mine > 0u ? mine : 1u; nx = cnt > 0u ? cnt : 1u;
}
__device__ __forceinline__ void xcd_barrier(const XcdBarrier& b) {
    asm volatile("s_waitcnt vmcnt(0)" ::: "memory");
    __syncthreads();
    if (threadIdx.x == 0) {
        unsigned* bar = b.bar;
        __builtin_amdgcn_s_waitcnt(0);
        unsigned nloc = b.st[0], nx = b.st[1];
        if (nloc == 0u) { xcd_barrier_complete(bar, b.x, nloc, nx); b.st[0] = nloc; b.st[1] = nx; }
        const unsigned old = xb_add(&bar[XB_XSUB(b.x)], 1u);
        const unsigned gen = old / nloc;
        if (old + 1u == (gen + 1u) * nloc) {
            __builtin_amdgcn_fence(__ATOMIC_RELEASE, "agent");
            asm volatile("s_waitcnt vmcnt(0)" ::: "memory");
            const unsigned og = xb_add(&bar[XB_TOP], 1u);
            const unsigned tg = og / nx;
            if (og + 1u == (tg + 1u) * nx) xb_add(&bar[XB_TOPGEN], 1u);
            else XB_SPIN(xb_ld(&bar[XB_TOPGEN]) == tg, bar);
            __builtin_amdgcn_fence(__ATOMIC_ACQUIRE, "agent");
            xb_add(&bar[XB_XGEN(b.x)], 1u);
            asm volatile("s_waitcnt vmcnt(0)" ::: "memory");
        } else {
            XB_SPIN(xb_ld(&bar[XB_XGEN(b.x)]) == gen, bar);
            __builtin_amdgcn_fence(__ATOMIC_ACQUIRE, "agent");
            asm volatile("s_waitcnt vmcnt(0)" ::: "memory");
        }
    }
    __syncthreads();
}

struct Args { const float* in[15]; float* out; unsigned char* ws; int ph_lo, ph_hi; };
constexpr int N_PHASES = 9;

__global__ void __launch_bounds__(NWAVES * 64, 2) mk_fwd(Args args) {
    extern __shared__ __attribute__((aligned(16))) unsigned char lds_raw[];
    LAS unsigned char* lds = (LAS unsigned char*)lds_raw;
    const int tid = threadIdx.x, lane = tid & 63, wave = __builtin_amdgcn_readfirstlane(tid >> 6);
    const int G = gridDim.x, bx = blockIdx.x;
    const int vcu = (G % 8 == 0) ? (bx % 8) * (G / 8) + bx / 8 : bx;
    const int gw = vcu * NWAVES + wave, NGW = G * NWAVES;
    unsigned char* ws = args.ws;
    const float* x = args.in[0]; const float* ln_in_g = args.in[1]; const float* ln_in_b = args.in[2]; const float* w_in = args.in[3]; const float* w_pool = args.in[4];
    const float* pool_scale = args.in[5]; const float* w_out = args.in[6]; const float* ln1_g = args.in[7]; const float* ln1_b = args.in[8]; const float* w_ff1 = args.in[9];
    const float* b_ff1 = args.in[10]; const float* w_ff2 = args.in[11]; const float* b_ff2 = args.in[12]; const float* ln2_g = args.in[13]; const float* ln2_b = args.in[14];
    float* out = args.out;
    float* mean0 = (float*)(ws + WS_STATS); float* rstd0 = mean0 + M; float* mean1 = rstd0 + M; float* rstd1 = mean1 + M;
    bf16_t* Win_t = (bf16_t*)(ws + WS_WIN); bf16_t* Wpool_t = (bf16_t*)(ws + WS_WPOOL); bf16_t* Wout_t = (bf16_t*)(ws + WS_WOUT); bf16_t* W1_t = (bf16_t*)(ws + WS_W1); bf16_t* W2_t = (bf16_t*)(ws + WS_W2);
    bf16_t* XN = (bf16_t*)(ws + WS_XN); bf16_t* U = (bf16_t*)(ws + WS_U); bf16_t* YP = (bf16_t*)(ws + WS_YP); bf16_t* MIX = (bf16_t*)(ws + WS_MIX); bf16_t* F = (bf16_t*)(ws + WS_F);
    const int lo = args.ph_lo, hi = args.ph_hi;
    volatile LAS unsigned* MISC = (volatile LAS unsigned*)(lds + 131072 + 320);
    if (tid < 32) MISC[tid] = 0u;
    __syncthreads();
    if (lo > 1000) cg::this_grid().sync();
    XcdBarrier bar; bar.bar = (unsigned*)ws; bar.x = 0; bar.st = nullptr;
    if (hi - lo > 1) bar = xcd_barrier_post((unsigned*)ws, MISC + 8);
#define IN(k) (lo <= (k) && (k) < hi)
#define SEAM(k) do { if (IN(k) && IN((k) + 1)) { xcd_barrier(bar); } } while (0)

    if (IN(0)) {
        LAS float* scr = (LAS float*)(lds + wave * 16384);
        constexpr int I_IN = (DM / 64) * (NIN / 32), I_POOL = (256 / 64) * (256 / 32), I_OUT = (DM / 64) * (DM / 32);
        constexpr int NITEMS = I_IN + 4 * I_POOL + I_OUT;
        for (int it = gw; it < NITEMS; it += NGW) {
            int r = it;
            if (r < I_IN) { p0_transpose_item(w_in, DM, NIN, Win_t, scr, r, lane); continue; } r -= I_IN;
            if (r < 4 * I_POOL) { const int gi = r / I_POOL; p0_transpose_item(w_pool + gi * 65536, 256, 256, Wpool_t + gi * 65536, scr, r % I_POOL, lane); continue; } r -= 4 * I_POOL;
            p0_transpose_item(w_out, DM, DM, Wout_t, scr, r, lane);
        }
        for (int m = gw; m < M; m += NGW) ln_row<true, false>(x + (size_t)m * DM, ln_in_g, ln_in_b, XN + (size_t)m * DM, nullptr, mean0 + m, rstd0 + m, lane);
        asm volatile("s_waitcnt vmcnt(0) lgkmcnt(0)" ::: "memory"); __syncthreads();
    }
    SEAM(0);
    if (IN(1)) {
        pg8::Gemm g{XN, Win_t, M, NIN, DM, DM, DM, 0}; pg8::StaticOrder S; S.init(M, NIN, G, bx);
        pg8::EpiBf16<0> E{U, NIN, nullptr, nullptr};
        pg8::gemm_phase<pg8::EpiBf16<0>, pg8::StaticOrder>(lds, g, S, E);
    }
    SEAM(1);
    if (IN(2)) {
        LAS unsigned char* vl = lds + wave * VTILE;
        constexpr int I_1 = (DM / 64) * (DFF / 32), I_2 = (DFF / 64) * (DM / 32);
#define CONV_W12() do { for (int it = gw; it < I_1 + I_2; it += NGW) { \
            if (it < I_1) p0_transpose_item(w_ff1, DM, DFF, W1_t, (LAS float*)vl, it, lane); \
            else p0_transpose_item(w_ff2, DFF, DM, W2_t, (LAS float*)vl, it - I_1, lane); } } while (0)
        if (wave & 1) CONV_W12();
        for (int u = gw; u < BATCH * NH * (SEQ / 32); u += NGW) {
            const int qb = u & 127, bh = u >> 7;
            sb_attn_unit(U, MIX, bh >> 3, bh & 7, qb, vl, lane);
        }
        for (int it = gw; it < (M / 8) * 4; it += NGW) pool_item(U, YP, POOLW, it, lane);
        if (!(wave & 1)) CONV_W12();
#undef CONV_W12
        asm volatile("s_waitcnt vmcnt(0) lgkmcnt(0)" ::: "memory"); __syncthreads();
    }
    SEAM(2);
    if (IN(3)) {
        pg8::Gemm g{YP, Wpool_t, M, POOLW, 256, POOLW, 256, 512}; pg8::StaticOrder S; S.init(M, POOLW, G, bx);
        pg8::EpiBf16<0> E{MIX, DM, nullptr, pool_scale};
        pg8::gemm_phase<pg8::EpiBf16<0>, pg8::StaticOrder>(lds, g, S, E);
    }
    SEAM(3);
    if (IN(4)) {
        pg8::Gemm g{MIX, Wout_t, M, DM, DM, DM, DM, 0}; pg8::StaticOrder S; S.init(M, DM, G, bx);
        pg8::EpiResF32 E{x, out, DM, nullptr, mean0, rstd0, ln_in_g, ln_in_b, ALPHA};
        pg8::gemm_phase<pg8::EpiResF32, pg8::StaticOrder>(lds, g, S, E);
    }
    SEAM(4);
    if (IN(5)) {
        for (int m = gw; m < M; m += NGW) ln_row<true, false>(out + (size_t)m * DM, ln1_g, ln1_b, XN + (size_t)m * DM, nullptr, mean1 + m, rstd1 + m, lane);
    }
    SEAM(5);
    if (IN(6)) {
        pg8::Gemm g{XN, W1_t, M, DFF, DM, DM, DM, 0}; pg8::StaticOrder S; S.init(M, DFF, G, bx);
        pg8::EpiBf16<2> E{F, DFF, b_ff1, nullptr};
        pg8::gemm_phase<pg8::EpiBf16<2>, pg8::StaticOrder>(lds, g, S, E);
    }
    SEAM(6);
    if (IN(7)) {
        pg8::Gemm g{F, W2_t, M, DM, DFF, DFF, DFF, 0}; pg8::StaticOrder S; S.init(M, DM, G, bx);
        pg8::EpiResF32 E{out, out, DM, b_ff2, mean1, rstd1, ln1_g, ln1_b, ALPHA};
        pg8::gemm_phase<pg8::EpiResF32, pg8::StaticOrder>(lds, g, S, E);
    }
    SEAM(7);
    if (IN(8)) {
        for (int m = gw; m < M; m += NGW) ln_row<false, true>(out + (size_t)m * DM, ln2_g, ln2_b, nullptr, out + (size_t)m * DM, nullptr, nullptr, lane);
    }
#undef IN
#undef SEAM
}

extern "C" void kernel_launch(void* const* d_in, const int* in_sizes, int n_in, void* d_out, int out_size, void* d_ws, size_t ws_size, hipStream_t stream) {
    static int grid = 0;
    if (grid == 0) {
        if (n_in != 15 || in_sizes[0] != M * DM || out_size != M * DM || ws_size < WS_END) { fprintf(stderr, "kernel_launch: unexpected shapes (n_in %d, in0 %d, out %d, ws %zu)\n", n_in, n_in > 0 ? in_sizes[0] : -1, out_size, ws_size); grid = -1; return; }
        int dev = 0, cus = 0, per_cu = 0;
        hipGetDevice(&dev); hipDeviceGetAttribute(&cus, hipDeviceAttributeMultiprocessorCount, dev);
        if (hipFuncSetAttribute((const void*)mk_fwd, hipFuncAttributeMaxDynamicSharedMemorySize, LDS_BYTES) != hipSuccess) { fprintf(stderr, "kernel_launch: hipFuncSetAttribute failed\n"); grid = -1; return; }
        if (hipOccupancyMaxActiveBlocksPerMultiprocessor(&per_cu, (const void*)mk_fwd, NWAVES * 64, LDS_BYTES) != hipSuccess || per_cu < 1) { fprintf(stderr, "kernel_launch: occupancy query says %d\n", per_cu); per_cu = 1; }
        (void)hipGetLastError();
        grid = cus * 1;
        if (grid <= 0) grid = 256;
    }
    if (grid < 0) return;
    if (hipMemsetAsync(d_ws, 0, 16384, stream) != hipSuccess) { fprintf(stderr, "kernel_launch: memset failed\n"); return; }
    Args a{};
    for (int i = 0; i < 15; ++i) a.in[i] = (const float*)d_in[i];
    a.out = (float*)d_out; a.ws = (unsigned char*)d_ws;
#if MK_N_LAUNCHES == 1
    a.ph_lo = 0; a.ph_hi = N_PHASES;
    void* kargs[] = {&a};
    hipError_t e = hipLaunchCooperativeKernel((const void*)mk_fwd, dim3(grid), dim3(NWAVES * 64), kargs, LDS_BYTES, stream);
    if (e != hipSuccess) fprintf(stderr, "cooperative launch failed: %s (grid %d)\n", hipGetErrorString(e), grid);
#else
    for (int p = 0; p < N_PHASES; ++p) { a.ph_lo = p; a.ph_hi = p + 1; hipLaunchKernelGGL(mk_fwd, dim3(grid), dim3(NWAVES * 64), LDS_BYTES, stream, a); }
#endif
}
```
